# Optimizing an MI355X kernel written in HIP

```python
import math
import jax, jax.numpy as jnp
from jax import lax
import numpy as np

D_MODEL = 1024
BATCH = 8
SEQ = 4096
DEPTH = 1

CHUNK = 64
D_MIX = D_MODEL
D_ATT = D_MIX // 2
N_ATT_HEADS = 8
ATT_HEAD_DIM = D_ATT // N_ATT_HEADS
LEFT_CHUNKS = 8
BAND = (LEFT_CHUNKS + 1) * CHUNK
REL_CLIP = 128
D_GLA_V = D_MIX - D_ATT
N_GLA_HEADS = 4
D_GLA_K = D_GLA_V // 2
GLA_HEAD_K = D_GLA_K // N_GLA_HEADS
GLA_HEAD_V = D_GLA_V // N_GLA_HEADS
GLA_LOW_RANK = 16
GLA_TAU = 16.0
D_PLE = 256
LN_EPS = 1e-5
RMS_EPS = 1e-6
DEEPNORM_ALPHA = (2.0 * DEPTH) ** 0.25
DEEPNORM_BETA = (8.0 * DEPTH) ** -0.25
D_IN_PROJ = 4 * D_ATT + 2 * D_GLA_K + 2 * D_GLA_V + GLA_LOW_RANK

kernel_name = "hymba_chunked_attn_gla_deepnorm"


def _split_sizes():
    return (D_ATT, D_ATT, D_ATT, D_ATT, D_GLA_K, D_GLA_K, D_GLA_V, D_GLA_V, GLA_LOW_RANK)


def layer_norm(x, g, b):
    xf = x.astype(jnp.float32)
    mu = jnp.mean(xf, axis=-1, keepdims=True)
    xc = xf - mu
    var = jnp.mean(xc * xc, axis=-1, keepdims=True)
    y = xc * lax.rsqrt(var + LN_EPS) * g.astype(jnp.float32) + b.astype(jnp.float32)
    return y.astype(x.dtype)


def chunk_band_attention(q, k, v, rel_table):
    b, s, h, dh = q.shape
    nc = s // CHUNK
    q = jnp.transpose(q, (0, 2, 1, 3))
    k = jnp.transpose(k, (0, 2, 1, 3))
    v = jnp.transpose(v, (0, 2, 1, 3))
    left = LEFT_CHUNKS * CHUNK
    k_pad = jnp.pad(k, ((0, 0), (0, 0), (left, 0), (0, 0)))
    v_pad = jnp.pad(v, ((0, 0), (0, 0), (left, 0), (0, 0)))
    q_chunks = jnp.moveaxis(q.reshape(b, h, nc, CHUNK, dh), 2, 0)
    qi = jnp.arange(CHUNK)[:, None]
    kj = jnp.arange(BAND)[None, :]
    rel = qi + left - kj
    rel_idx = jnp.clip(rel, -REL_CLIP, REL_CLIP) + REL_CLIP
    bias = rel_table.astype(jnp.float32)[:, rel_idx]
    scale = ATT_HEAD_DIM ** -0.5

    def one_chunk(args):
        c, q_blk = args
        start = c * CHUNK
        k_blk = lax.dynamic_slice_in_dim(k_pad, start, BAND, axis=2)
        v_blk = lax.dynamic_slice_in_dim(v_pad, start, BAND, axis=2)
        sc = jnp.einsum('bhqd,bhkd->bhqk', q_blk, k_blk).astype(jnp.float32) * scale + bias
        valid = (start - left + kj) >= 0
        sc = jnp.where(valid, sc, -1e30)
        pr = jax.nn.softmax(sc, axis=-1)
        return jnp.einsum('bhqk,bhkd->bhqd', pr.astype(v_blk.dtype), v_blk)

    out = lax.map(one_chunk, (jnp.arange(nc), q_chunks))
    out = jnp.transpose(out, (1, 0, 3, 2, 4))
    return out.reshape(b, s, h * dh)


def gla_chunked(q, k, v, log_a):
    b, s, h, dk = q.shape
    dv = v.shape[-1]
    nc = s // CHUNK
    f32 = jnp.float32
    qf = q.astype(f32).reshape(b, nc, CHUNK, h, dk) * (dk ** -0.5)
    kf = k.astype(f32).reshape(b, nc, CHUNK, h, dk)
    vf = v.astype(f32).reshape(b, nc, CHUNK, h, dv)
    L = jnp.cumsum(log_a.astype(f32).reshape(b, nc, CHUNK, h, dk), axis=2)
    L_end = L[:, :, -1:]
    eL = jnp.exp(L)
    e_negL = jnp.exp(-L)
    q_fwd = qf * eL
    a_causal = jnp.einsum('bnthd,bnshd->bnhts', q_fwd, kf * e_negL)
    a_anti = jnp.einsum('bnthd,bnshd->bnhts', qf * e_negL, kf * eL)
    tril = jnp.tril(jnp.ones((CHUNK, CHUNK), dtype=bool))
    att = jnp.where(tril, a_causal, a_anti)
    o_intra = jnp.einsum('bnhts,bnshv->bnthv', att, vf)
    kv = jnp.einsum('bnshd,bnshv->bnhdv', kf * jnp.exp(L_end - L), vf)
    chunk_decay = jnp.exp(L_end[:, :, 0])

    def step(state, inp):
        dec, kv_c = inp
        return dec[..., None] * state + kv_c, state

    init = jnp.zeros((b, h, dk, dv), f32)
    _, s_prev = lax.scan(step, init, (jnp.moveaxis(chunk_decay, 1, 0), jnp.moveaxis(kv, 1, 0)))
    s_prev = jnp.moveaxis(s_prev, 0, 1)
    o_inter = jnp.einsum('bnthd,bnhdv->bnthv', q_fwd, s_prev)
    return (o_intra + o_inter).reshape(b, s, h, dv)


def setup_inputs(seed: int = 0) -> dict:
    key = jax.random.key(seed)
    ks = jax.random.split(key, 20)
    f32 = jnp.float32
    n = jax.random.normal
    x = n(ks[0], (BATCH, SEQ, D_MODEL), f32)
    p = n(ks[1], (DEPTH, BATCH, SEQ, D_PLE), f32)
    ln_in_g = 1.0 + 0.02 * n(ks[2], (D_MODEL,), f32)
    ln_in_b = 0.02 * n(ks[3], (D_MODEL,), f32)
    w_in = n(ks[4], (DEPTH, D_MODEL, D_IN_PROJ), f32) * D_MODEL ** -0.5
    w_gla_gate = n(ks[5], (DEPTH, GLA_LOW_RANK, D_GLA_K), f32) * GLA_LOW_RANK ** -0.5
    b_gla_gate = 0.1 * n(ks[6], (DEPTH, D_GLA_K), f32) + 1.0
    rel_bias = 0.1 * n(ks[7], (DEPTH, N_ATT_HEADS, 2 * REL_CLIP + 1), f32)
    gla_norm_g = 1.0 + 0.02 * n(ks[8], (DEPTH, N_GLA_HEADS, GLA_HEAD_V), f32)
    w_out = n(ks[9], (DEPTH, D_MIX, D_MODEL), f32) * (D_MIX ** -0.5) * DEEPNORM_BETA
    w_ple = n(ks[10], (DEPTH, D_PLE, D_MODEL), f32) * D_PLE ** -0.5
    w_ple_gate = n(ks[11], (DEPTH, D_MODEL, D_MODEL), f32) * D_MODEL ** -0.5
    b_ple_gate = 0.02 * n(ks[12], (DEPTH, D_MODEL), f32)
    ln_g = 1.0 + 0.02 * n(ks[13], (DEPTH, D_MODEL), f32)
    ln_b = 0.02 * n(ks[14], (DEPTH, D_MODEL), f32)
    return {"x": x, "p": p, "ln_in_g": ln_in_g, "ln_in_b": ln_in_b, "w_in": w_in,
            "w_gla_gate": w_gla_gate, "b_gla_gate": b_gla_gate, "rel_bias": rel_bias,
            "gla_norm_g": gla_norm_g, "w_out": w_out, "w_ple": w_ple,
            "w_ple_gate": w_ple_gate, "b_ple_gate": b_ple_gate, "ln_g": ln_g, "ln_b": ln_b}


def reference(x, p, ln_in_g, ln_in_b, w_in, w_gla_gate, b_gla_gate, rel_bias,
              gla_norm_g, w_out, w_ple, w_ple_gate, b_ple_gate, ln_g, ln_b):
    b, s, _ = x.shape
    split_points = np.cumsum(np.array(_split_sizes()))[:-1].tolist()
    h = layer_norm(x, ln_in_g, ln_in_b)
    for i in range(DEPTH):
        proj = h @ w_in[i]
        (aq, ak, av, ag, gq, gk, gv, gg, glr) = jnp.split(proj, split_points, axis=-1)
        att = chunk_band_attention(
            aq.reshape(b, s, N_ATT_HEADS, ATT_HEAD_DIM),
            ak.reshape(b, s, N_ATT_HEADS, ATT_HEAD_DIM),
            av.reshape(b, s, N_ATT_HEADS, ATT_HEAD_DIM),
            rel_bias[i])
        att = att * jax.nn.silu(ag)
        gate_logit = (glr @ w_gla_gate[i] + b_gla_gate[i]).astype(jnp.float32)
        log_a = jax.nn.log_sigmoid(gate_logit) / GLA_TAU
        o = gla_chunked(
            gq.reshape(b, s, N_GLA_HEADS, GLA_HEAD_K),
            gk.reshape(b, s, N_GLA_HEADS, GLA_HEAD_K),
            gv.reshape(b, s, N_GLA_HEADS, GLA_HEAD_V),
            log_a.reshape(b, s, N_GLA_HEADS, GLA_HEAD_K))
        o = o * lax.rsqrt(jnp.mean(o * o, axis=-1, keepdims=True) + RMS_EPS) \
            * gla_norm_g[i].astype(jnp.float32)
        gla = o.reshape(b, s, D_GLA_V).astype(h.dtype) * jax.nn.silu(gg)
        mix = jnp.concatenate([att.astype(h.dtype), gla], axis=-1) @ w_out[i]
        r = DEEPNORM_ALPHA * h + mix
        ple_gate = jax.nn.sigmoid(r @ w_ple_gate[i] + b_ple_gate[i])
        r = r + ple_gate * (p[i] @ w_ple[i])
        h = layer_norm(r, ln_g[i], ln_b[i])
    return h
```

```cpp
#include <hip/hip_runtime.h>
#include <hip/hip_cooperative_groups.h>
#include <cstdio>
#include <cstdint>
namespace cg = cooperative_groups;
#ifndef DUP_ATTN
#define DUP_ATTN 1
#endif
#ifndef DUP_KV
#define DUP_KV 1
#endif
#ifndef DUP_OUT
#define DUP_OUT 1
#endif
#ifndef DUP_G1
#define DUP_G1 1
#endif
__device__ __forceinline__ int opaque_tid_g() { int t = threadIdx.x; asm volatile("" : "+v"(t)); return t; }
namespace pg8 {
#define PG8_LAS __attribute__((address_space(3)))
typedef unsigned short bf16_t;
typedef short bf16x8 __attribute__((ext_vector_type(8)));
typedef float f32x4 __attribute__((ext_vector_type(4)));
typedef unsigned u32x4 __attribute__((ext_vector_type(4)));
constexpr int BM = 256, BK = 64, HALF = 128, HTB = HALF * BK * 2  , STAGE_BYTES = 8 * HTB, NXCD = 8, WGM = 8;

__host__ __device__ __forceinline__ int lds_byte(int r, int c) { const int st = (r >> 4) * 2 + (c >> 5), rr = r & 15, cc = c & 31, ob = rr * 64 + cc * 2; return st * 1024 + (ob ^ (((ob >> 9) & 1) << 5)); }
__host__ __device__ __forceinline__ void stage_rc(int b, int& R, int& C) { const int st = b / 1024, sb = b % 1024, swz = sb ^ (((sb >> 9) & 1) << 5); R = (st >> 1) * 16 + swz / 64; C = (st & 1) * 32 + (swz % 64) / 2; }
__host__ __device__ __forceinline__ int perm32(int rho) { const int n = rho >> 4, i = rho & 15; return 8 * (i >> 2) + 4 * n + (i & 3); }

struct Unit { int pm, pn; };
struct Gemm { const bf16_t* A; const bf16_t* Bt; int M, N, K; };

struct StaticOrder {
    int nM, nN, nwg, G, c;
    __host__ __device__ void init(int M, int N, int G_, int c_) { nM = M / BM; nN = N / BM; nwg = nM * nN; G = G_; c = c_; }
    __host__ __device__ bool next(int i, Unit& u) const {
        const long L = (long)i * G + c; if (L >= nwg) return false;
        int wgid = (int)L; { const int q = nwg / NXCD, r = nwg % NXCD, xcd = wgid % NXCD, off = wgid / NXCD; wgid = (xcd < r ? xcd * (q + 1) : r * (q + 1) + (xcd - r) * q) + off; }
        const int nig = WGM * nN, gid = wgid / nig, fm = gid * WGM, gsz = (nM - fm) < WGM ? (nM - fm) : WGM;
        u.pm = fm + ((wgid % nig) % gsz); u.pn = (wgid % nig) / gsz; return true;
    }
    __device__ __forceinline__ void a_ready(const Unit&) const {}
    __device__ __forceinline__ void done(const Unit&) const {}
};

template <class Epi, class Sched, bool ALIGN_EPI = false, bool SP2 = false>
__device__ __forceinline__ void gemm_phase(PG8_LAS unsigned char* lds, const Gemm g, const Sched& S, const Epi& E) {
    const int tid = opaque_tid_g(), wid = __builtin_amdgcn_readfirstlane(tid >> 6), lane = tid & 63, wr = wid >> 2, wc = wid & 3, fr = lane & 15, fq = lane >> 4;
    const int K = g.K, nt = K / BK;
    unsigned voffA[2], voffB[2];
#pragma unroll
    for (int i = 0; i < 2; ++i) { int R, C; stage_rc(tid * 16 + i * 8192, R, C); const int Rb = Epi::PERM ? ((R & ~31) + perm32(R & 31)) : R;
        voffA[i] = (unsigned)(R * K + C) * 2u; voffB[i] = (unsigned)(Rb * K + C) * 2u; }
    const size_t kstep = (size_t)(BK * 2);
    const size_t hstep = (size_t)HALF * K * 2;
    const size_t tstep = 2 * hstep;
    const unsigned ldsw = (unsigned)wid * 1024u;
    const int aoff = lds_byte(wr * 64 + fr, fq * 8), boff = lds_byte(wc * 32 + fr, fq * 8);
#define PG8_SA(b, h) (((b) * 2 + (h)) * HTB)
#define PG8_SB(b, h) ((4 + (b) * 2 + (h)) * HTB)
#define PG8_STAGE(bufoff, gbase, voff) do { _Pragma("unroll") for (int _i = 0; _i < 2; ++_i) \
        __builtin_amdgcn_global_load_lds((const unsigned*)((const char*)(gbase) + (voff)[_i]), (PG8_LAS unsigned*)(lds + (bufoff) + ldsw + _i * 8192), 16, 0, 0); } while (0)
#define PG8_LDA(dst, b, h) do { _Pragma("unroll") for (int m = 0; m < 4; ++m) _Pragma("unroll") for (int k = 0; k < 2; ++k) dst[m][k] = *(const PG8_LAS bf16x8*)(lds + PG8_SA(b, h) + aoff + m * 2048 + k * 1024); } while (0)
#define PG8_LDB(dst, b, h) do { _Pragma("unroll") for (int n = 0; n < 2; ++n) _Pragma("unroll") for (int k = 0; k < 2; ++k) dst[n][k] = *(const PG8_LAS bf16x8*)(lds + PG8_SB(b, h) + boff + n * 2048 + k * 1024); } while (0)
#define PG8_MMA(ai, bj, At, Bt) do { __builtin_amdgcn_s_setprio(1); _Pragma("unroll") for (int m = 0; m < 4; ++m) _Pragma("unroll") for (int n = 0; n < 2; ++n) _Pragma("unroll") for (int k = 0; k < 2; ++k) \
        acc[ai][bj][m][n] = __builtin_amdgcn_mfma_f32_16x16x32_bf16(Bt[n][k], At[m][k], acc[ai][bj][m][n], 0, 0, 0); __builtin_amdgcn_s_setprio(0); } while (0)
#define PG8_WAIT_V(n) asm volatile("s_waitcnt vmcnt(" #n ")" ::: "memory")
#define PG8_WAIT_L(n) asm volatile("s_waitcnt lgkmcnt(" #n ")" ::: "memory")
#define PG8_BAR __builtin_amdgcn_s_barrier()
#define PG8_SCHED __builtin_amdgcn_sched_barrier(0)
    Unit cur, nxt; int ui = 0;
    if (!S.next(0, cur)) return;
    f32x4 acc[2][2][4][2];
#pragma unroll
    for (int a = 0; a < 2; ++a)
#pragma unroll
        for (int b = 0; b < 2; ++b)
#pragma unroll
            for (int m = 0; m < 4; ++m)
#pragma unroll
                for (int n = 0; n < 2; ++n) acc[a][b][m][n] = (f32x4){0.f, 0.f, 0.f, 0.f};
    bf16x8 At[4][2], B0[2][2], B1[2][2];
    const char* cA = (const char*)g.A + (size_t)cur.pm * tstep; const char* cB = (const char*)g.Bt + (size_t)cur.pn * tstep;
    S.a_ready(cur);
    if constexpr (SP2) {
        PG8_STAGE(PG8_SB(0, 0), cB, voffB); PG8_STAGE(PG8_SB(0, 1), cB + hstep, voffB); PG8_STAGE(PG8_SA(0, 0), cA, voffA); PG8_STAGE(PG8_SA(0, 1), cA + hstep, voffA);
        if (wr == 1) PG8_BAR;
        PG8_WAIT_V(2); PG8_BAR;
        PG8_STAGE(PG8_SB(1, 0), cB + kstep, voffB); PG8_STAGE(PG8_SA(1, 0), cA + kstep, voffA); PG8_STAGE(PG8_SB(1, 1), cB + hstep + kstep, voffB);
        PG8_WAIT_V(6); PG8_BAR;
    } else {
        PG8_STAGE(PG8_SB(0, 0), cB, voffB); PG8_STAGE(PG8_SA(0, 0), cA, voffA); PG8_STAGE(PG8_SB(0, 1), cB + hstep, voffB); PG8_STAGE(PG8_SA(0, 1), cA + hstep, voffA);
        if (wr == 1) PG8_BAR;
        PG8_WAIT_V(4); PG8_BAR;
        PG8_STAGE(PG8_SB(1, 0), cB + kstep, voffB); PG8_STAGE(PG8_SA(1, 0), cA + kstep, voffA); PG8_STAGE(PG8_SB(1, 1), cB + hstep + kstep, voffB);
        PG8_WAIT_V(6); PG8_BAR;
    }
    for (;;) {
        const bool has_next = S.next(ui + 1, nxt);
        const char* nA = has_next ? (const char*)g.A + (size_t)nxt.pm * tstep : cA; const char* nB = has_next ? (const char*)g.Bt + (size_t)nxt.pn * tstep : cB;
        for (int t = 0; t < nt; t += 2) {
            const bool last = (t == nt - 2);
            const char* a1 = cA + (size_t)(t + 1) * kstep;
            const char* a2 = last ? nA : cA + (size_t)(t + 2) * kstep; const char* b2 = last ? nB : cB + (size_t)(t + 2) * kstep;
            const char* a3 = a2 + kstep; const char* b3 = b2 + kstep;
            if (last && has_next) S.a_ready(nxt);
            if constexpr (SP2) {
            PG8_LDB(B0, 0, 0); PG8_LDB(B1, 0, 1); PG8_SCHED; PG8_LDA(At, 0, 0); PG8_STAGE(PG8_SA(1, 1), a1 + hstep, voffA);
            PG8_WAIT_V(8); PG8_WAIT_L(0); PG8_BAR; PG8_MMA(0, 0, At, B0); PG8_MMA(0, 1, At, B1); PG8_BAR; PG8_SCHED;
            PG8_LDA(At, 0, 1); PG8_STAGE(PG8_SB(0, 0), b2, voffB); PG8_STAGE(PG8_SB(0, 1), b2 + hstep, voffB); PG8_STAGE(PG8_SA(0, 0), a2, voffA);
            PG8_WAIT_V(8); PG8_WAIT_L(0); PG8_BAR; PG8_MMA(1, 0, At, B0); PG8_MMA(1, 1, At, B1); PG8_BAR; PG8_SCHED;
            PG8_LDB(B0, 1, 0); PG8_LDB(B1, 1, 1); PG8_SCHED; PG8_LDA(At, 1, 0); PG8_STAGE(PG8_SA(0, 1), a2 + hstep, voffA);
            PG8_WAIT_V(8); PG8_WAIT_L(0); PG8_BAR; PG8_MMA(0, 0, At, B0); PG8_MMA(0, 1, At, B1); PG8_BAR; PG8_SCHED;
            PG8_LDA(At, 1, 1); PG8_STAGE(PG8_SB(1, 0), b3, voffB); PG8_STAGE(PG8_SB(1, 1), b3 + hstep, voffB); PG8_STAGE(PG8_SA(1, 0), a3, voffA);
            PG8_WAIT_V(8); PG8_WAIT_L(0); PG8_BAR; PG8_MMA(1, 0, At, B0); PG8_MMA(1, 1, At, B1); PG8_BAR; PG8_SCHED;
            } else {
            PG8_LDB(B0, 0, 0); PG8_SCHED; PG8_LDA(At, 0, 0); PG8_STAGE(PG8_SA(1, 1), a1 + hstep, voffA);
            PG8_WAIT_L(8); PG8_BAR; PG8_WAIT_L(0); PG8_MMA(0, 0, At, B0); PG8_BAR; PG8_SCHED;
            PG8_LDB(B1, 0, 1); PG8_STAGE(PG8_SB(0, 0), b2, voffB);
            PG8_BAR; PG8_WAIT_L(0); PG8_MMA(0, 1, At, B1); PG8_BAR;
            PG8_LDA(At, 0, 1); PG8_STAGE(PG8_SA(0, 0), a2, voffA);
            PG8_BAR; PG8_WAIT_L(0); PG8_MMA(1, 0, At, B0); PG8_BAR; PG8_SCHED;
            PG8_STAGE(PG8_SB(0, 1), b2 + hstep, voffB);
            PG8_WAIT_V(6); PG8_BAR; PG8_MMA(1, 1, At, B1); PG8_BAR;
            PG8_LDB(B0, 1, 0); PG8_SCHED; PG8_LDA(At, 1, 0); PG8_STAGE(PG8_SA(0, 1), a2 + hstep, voffA);
            PG8_WAIT_L(8); PG8_BAR; PG8_WAIT_L(0); PG8_MMA(0, 0, At, B0); PG8_BAR; PG8_SCHED;
            PG8_LDB(B1, 1, 1); PG8_STAGE(PG8_SB(1, 0), b3, voffB);
            PG8_BAR; PG8_WAIT_L(0); PG8_MMA(0, 1, At, B1); PG8_BAR;
            PG8_LDA(At, 1, 1); PG8_STAGE(PG8_SA(1, 0), a3, voffA);
            PG8_BAR; PG8_WAIT_L(0); PG8_MMA(1, 0, At, B0); PG8_BAR; PG8_SCHED;
            PG8_STAGE(PG8_SB(1, 1), b3 + hstep, voffB);
            PG8_WAIT_V(6); PG8_BAR; PG8_MMA(1, 1, At, B1); PG8_BAR;
            }
        }
        if constexpr (ALIGN_EPI) { if (wr == 0) PG8_BAR; }
        if constexpr (!Epi::AFTER_DRAIN) { E(acc, cur, wr, wc, fr, fq); S.done(cur); }
        if (!has_next) break;
#pragma unroll
        for (int a = 0; a < 2; ++a)
#pragma unroll
            for (int b = 0; b < 2; ++b)
#pragma unroll
                for (int m = 0; m < 4; ++m)
#pragma unroll
                    for (int n = 0; n < 2; ++n) acc[a][b][m][n] = (f32x4){0.f, 0.f, 0.f, 0.f};
        cur = nxt; cA = nA; cB = nB; ++ui;
        if constexpr (ALIGN_EPI) { if (wr == 1) PG8_BAR; }
    }
    PG8_WAIT_V(0);
    if constexpr (!ALIGN_EPI) { if (wr == 0) PG8_BAR; }
    PG8_BAR;
    if constexpr (Epi::AFTER_DRAIN) { E.fused(acc, cur, wr, wc, fr, fq, lds, wid, lane); S.done(cur); }
#undef PG8_SA
#undef PG8_SB
#undef PG8_STAGE
#undef PG8_LDA
#undef PG8_LDB
#undef PG8_MMA
#undef PG8_WAIT_V
#undef PG8_WAIT_L
#undef PG8_BAR
#undef PG8_SCHED
}
}

using pg8::bf16_t; using pg8::bf16x8; using pg8::f32x4; using pg8::u32x4;
typedef unsigned u32x2 __attribute__((ext_vector_type(2)));
constexpr int T_TOK = 32768, DM = 1024, SEQ = 4096, NPROJ = 3600, NPAD = 3840, DPLE = 256;
constexpr int C_AQ = 0, C_AK = 512, C_AV = 1024, C_AG = 1536, C_GQ = 2048, C_GK = 2304, C_GV = 2560, C_GG = 3072, C_LR = 3584;
constexpr float ALPHA = 1.189207115002721f;
constexpr int NTHR = 512, NWAVES = 8;
constexpr int LDS_BYTES = 156 * 1024;
constexpr size_t WS_WIN = 0;
constexpr size_t WS_WOUT = WS_WIN + (size_t)NPAD * DM * 2;
constexpr size_t WS_WG = WS_WOUT + (size_t)DM * DM * 2;
constexpr size_t WS_WP = WS_WG + (size_t)DM * DM * 2;
constexpr size_t WS_STATS = WS_WP + (size_t)DM * DPLE * 2;
constexpr size_t WS_DEC = WS_STATS + (size_t)T_TOK * 8;
constexpr size_t WS_HBF = WS_DEC + (size_t)32 * 64 * 64 * 4;
constexpr size_t WS_PBF = WS_HBF + (size_t)T_TOK * DM * 2;
constexpr size_t WS_PROJ = WS_PBF + (size_t)T_TOK * DPLE * 2;
constexpr size_t WS_R32 = WS_PROJ + (size_t)T_TOK * DM * 2;
constexpr size_t WS_MIX = WS_PROJ + (size_t)T_TOK * NPROJ * 2;
constexpr size_t WS_KV = WS_MIX + (size_t)T_TOK * DM * 2;
constexpr size_t WS_SPREV = WS_KV + (size_t)32 * 64 * 128 * 64 * 4;
constexpr size_t WS_EG = WS_SPREV + (size_t)32 * 64 * 128 * 64 * 2;
constexpr size_t WS_BAR = WS_EG + (size_t)2048 * 4096 * 2;
constexpr size_t WS_END = WS_BAR + 16384;

struct Params {
    const float* x; const float* p; const float* ln_in_g; const float* ln_in_b; const float* w_in; const float* w_gla_gate; const float* b_gla_gate;
    const float* rel_bias; const float* gla_norm_g; const float* w_out; const float* w_ple; const float* w_ple_gate; const float* b_ple_gate;
    const float* ln_g; const float* ln_b; float* out; unsigned char* ws;
};

typedef __bf16 bf16x2_hw __attribute__((ext_vector_type(2)));
typedef float f32x2_hw __attribute__((ext_vector_type(2)));
typedef short s16x4 __attribute__((ext_vector_type(4)));
__device__ __forceinline__ unsigned pk2(float lo, float hi) { f32x2_hw v = {lo, hi}; bf16x2_hw b = __builtin_convertvector(v, bf16x2_hw); return __builtin_bit_cast(unsigned, b); }
__device__ __forceinline__ unsigned f2bf(float f) { return pk2(f, 0.f) & 0xffffu; }
__device__ __forceinline__ s16x4 tr_read(PG8_LAS const unsigned char* p) { return __builtin_amdgcn_ds_read_tr16_b64_v4i16((PG8_LAS s16x4*)p); }
__device__ __forceinline__ float bflo(unsigned u) { return __builtin_bit_cast(float, u << 16); }
__device__ __forceinline__ float bfhi(unsigned u) { return __builtin_bit_cast(float, u & 0xffff0000u); }
__device__ __forceinline__ float bf2f(bf16_t v) { return __builtin_bit_cast(float, (unsigned)v << 16); }
__device__ __forceinline__ float wave_sum(float v) {
#pragma unroll
    for (int o = 1; o < 64; o <<= 1) v += __shfl_xor(v, o);
    return v;
}
__device__ __forceinline__ int opaque_tid() { int t = threadIdx.x; asm volatile("" : "+v"(t)); return t; }
__device__ __forceinline__ void lds_barrier() { asm volatile("s_waitcnt lgkmcnt(0)" ::: "memory"); __builtin_amdgcn_s_barrier(); asm volatile("" ::: "memory"); }
__device__ __forceinline__ float max_rows4(float v) {
    float a = v, b = v;
    asm("s_nop 1\n\tv_permlane16_swap_b32 %0, %1" : "+v"(a), "+v"(b));
    a = fmaxf(a, b); b = a;
    asm("s_nop 1\n\tv_permlane32_swap_b32 %0, %1" : "+v"(a), "+v"(b));
    return fmaxf(a, b);
}
__device__ __forceinline__ float sum_rows4(float v) {
    float a = v, b = v;
    asm("s_nop 1\n\tv_permlane16_swap_b32 %0, %1" : "+v"(a), "+v"(b));
    a = a + b; b = a;
    asm("s_nop 1\n\tv_permlane32_swap_b32 %0, %1" : "+v"(a), "+v"(b));
    return a + b;
}
__device__ __forceinline__ float sigmoidf_(float z) { return __builtin_amdgcn_rcpf(1.f + __expf(-z)); }
__device__ __forceinline__ float siluf_(float z) { return z * __builtin_amdgcn_rcpf(1.f + __expf(-z)); }
__device__ __forceinline__ f32x4 mfma16(bf16x8 a, bf16x8 b, f32x4 c) { return __builtin_amdgcn_mfma_f32_16x16x32_bf16(a, b, c, 0, 0, 0); }

__device__ __forceinline__ void transpose_item(const float* W, int K, int N, int nblk, bf16_t* WT, float* scr, int item, int lane) {
    const int kb = item / nblk, nb = item - kb * nblk, k0 = 64 * kb, n0 = 32 * nb;
    const int nn = n0 + (lane & 31);
#pragma unroll 8
    for (int i = 0; i < 32; ++i) { const int kk = 2 * i + (lane >> 5); scr[kk * 33 + (lane & 31)] = (nn < N) ? W[(size_t)(k0 + kk) * N + nn] : 0.f; }
    asm volatile("s_waitcnt lgkmcnt(0)" ::: "memory");
    const int c = lane & 7;
#pragma unroll
    for (int j = 0; j < 4; ++j) { const int n = (lane >> 3) + 8 * j; const float* s = scr + (8 * c) * 33 + n;
        u32x4 o; o.x = pk2(s[0 * 33], s[1 * 33]); o.y = pk2(s[2 * 33], s[3 * 33]); o.z = pk2(s[4 * 33], s[5 * 33]); o.w = pk2(s[6 * 33], s[7 * 33]);
        *(u32x4*)(WT + (size_t)(n0 + n) * K + k0 + 8 * c) = o; }
    asm volatile("s_waitcnt lgkmcnt(0)" ::: "memory");
}

__device__ __forceinline__ void prep_phase(const Params& P, unsigned char* lds) {
    const int tid = threadIdx.x, wave = tid >> 6, lane = tid & 63;
    unsigned char* ws = P.ws;
    float* scr = (float*)(lds + wave * 16384);
    const int gw = blockIdx.x * NWAVES + wave, NGW = gridDim.x * NWAVES;
    constexpr int I_IN = (DM / 64) * (NPAD / 32), I_OUT = (DM / 64) * (DM / 32), I_P = (DPLE / 64) * (DM / 32);
    constexpr int NITEMS = I_IN + 2 * I_OUT + I_P;
    for (int it = gw; it < NITEMS; it += NGW) {
        int r = it;
        if (r < I_IN) { transpose_item(P.w_in, DM, NPROJ, NPAD / 32, (bf16_t*)(ws + WS_WIN), scr, r, lane); continue; } r -= I_IN;
        if (r < I_OUT) { transpose_item(P.w_out, DM, DM, DM / 32, (bf16_t*)(ws + WS_WOUT), scr, r, lane); continue; } r -= I_OUT;
        if (r < I_OUT) { transpose_item(P.w_ple_gate, DM, DM, DM / 32, (bf16_t*)(ws + WS_WG), scr, r, lane); continue; } r -= I_OUT;
        transpose_item(P.w_ple, DPLE, DM, DM / 32, (bf16_t*)(ws + WS_WP), scr, r, lane);
    }
    bf16_t* hbf = (bf16_t*)(ws + WS_HBF);
    f32x4 gg[4], bb[4];
#pragma unroll
    for (int j = 0; j < 4; ++j) { gg[j] = ((const f32x4*)P.ln_in_g)[lane + 64 * j]; bb[j] = ((const f32x4*)P.ln_in_b)[lane + 64 * j]; }
    for (int m = gw; m < T_TOK; m += 2 * NGW) {
        const int m2 = m + NGW; const bool has2 = m2 < T_TOK;
        const f32x4* xr = (const f32x4*)(P.x + (size_t)m * DM) + lane;
        const f32x4* xr2 = (const f32x4*)(P.x + (size_t)(has2 ? m2 : m) * DM) + lane;
        f32x4 v[4], w[4]; float s = 0.f, sb = 0.f;
#pragma unroll
        for (int j = 0; j < 4; ++j) { v[j] = xr[64 * j]; w[j] = xr2[64 * j]; }
#pragma unroll
        for (int j = 0; j < 4; ++j) { s += (v[j].x + v[j].y) + (v[j].z + v[j].w); sb += (w[j].x + w[j].y) + (w[j].z + w[j].w); }
        const float mean = wave_sum(s) * (1.f / DM), meanb = wave_sum(sb) * (1.f / DM); float s2 = 0.f, s2b = 0.f;
#pragma unroll
        for (int j = 0; j < 4; ++j) { v[j] = v[j] - mean; s2 += (v[j].x * v[j].x + v[j].y * v[j].y) + (v[j].z * v[j].z + v[j].w * v[j].w);
                                      w[j] = w[j] - meanb; s2b += (w[j].x * w[j].x + w[j].y * w[j].y) + (w[j].z * w[j].z + w[j].w * w[j].w); }
        const float rstd = __builtin_amdgcn_rsqf(wave_sum(s2) * (1.f / DM) + 1e-5f), rstdb = __builtin_amdgcn_rsqf(wave_sum(s2b) * (1.f / DM) + 1e-5f);
        u32x2* o8 = (u32x2*)(hbf + (size_t)m * DM) + lane;
#pragma unroll
        for (int j = 0; j < 4; ++j) { const f32x4 y = v[j] * rstd * gg[j] + bb[j]; u32x2 o; o.x = pk2(y.x, y.y); o.y = pk2(y.z, y.w); o8[64 * j] = o; }
        if (has2) { u32x2* o82 = (u32x2*)(hbf + (size_t)m2 * DM) + lane;
#pragma unroll
            for (int j = 0; j < 4; ++j) { const f32x4 y = w[j] * rstdb * gg[j] + bb[j]; u32x2 o; o.x = pk2(y.x, y.y); o.y = pk2(y.z, y.w); o82[64 * j] = o; } }
    }
    bf16_t* pbf = (bf16_t*)(ws + WS_PBF);
    for (size_t i = (size_t)blockIdx.x * NTHR + tid; i < (size_t)T_TOK * DPLE / 8; i += (size_t)gridDim.x * NTHR) {
        const f32x4 a = ((const f32x4*)P.p)[2 * i], b = ((const f32x4*)P.p)[2 * i + 1];
        u32x4 o; o.x = pk2(a.x, a.y); o.y = pk2(a.z, a.w); o.z = pk2(b.x, b.y); o.w = pk2(b.z, b.w);
        ((u32x4*)pbf)[i] = o;
    }
}

struct EpiBf16 {
    static constexpr bool PERM = true, AFTER_DRAIN = false;
    bf16_t* O; int ldc; int ncols;
    __device__ __forceinline__ void operator()(const f32x4 (&acc)[2][2][4][2], const pg8::Unit& u, int wr, int wc, int fr, int fq) const {
        const int row0 = u.pm * 256 + wr * 64 + fr, col0 = u.pn * 256 + wc * 32 + 8 * fq;
#pragma unroll
        for (int ai = 0; ai < 2; ++ai)
#pragma unroll
            for (int m = 0; m < 4; ++m) { bf16_t* rowp = O + (size_t)(row0 + ai * 128 + m * 16) * ldc;
#pragma unroll
                for (int bj = 0; bj < 2; ++bj) { const int c = col0 + bj * 128;
                    if (c < ncols) { const f32x4 v0 = acc[ai][bj][m][0], v1 = acc[ai][bj][m][1];
                        u32x4 o; o.x = pk2(v0[0], v0[1]); o.y = pk2(v0[2], v0[3]); o.z = pk2(v1[0], v1[1]); o.w = pk2(v1[2], v1[3]);
                        *(u32x4*)(rowp + c) = o; } } }
    }
};
struct EpiRes {
    static constexpr bool PERM = true, AFTER_DRAIN = false;
    const bf16_t* hbf; bf16_t* rbf;
    __device__ __forceinline__ void operator()(const f32x4 (&acc)[2][2][4][2], const pg8::Unit& u, int wr, int wc, int fr, int fq) const {
        const int row0 = u.pm * 256 + wr * 64 + fr, col0 = u.pn * 256 + wc * 32 + 8 * fq;
#pragma unroll
        for (int bj = 0; bj < 2; ++bj) { const int c = col0 + bj * 128;
#pragma unroll
            for (int ai = 0; ai < 2; ++ai)
#pragma unroll
                for (int m = 0; m < 4; ++m) { const size_t row = (size_t)(row0 + ai * 128 + m * 16);
                    const u32x4 hh = *(const u32x4*)(hbf + row * DM + c);
                    const f32x4 a0 = acc[ai][bj][m][0], a1 = acc[ai][bj][m][1];
                    u32x4 o; o.x = pk2(bflo(hh.x) * ALPHA + a0[0], bfhi(hh.x) * ALPHA + a0[1]); o.y = pk2(bflo(hh.y) * ALPHA + a0[2], bfhi(hh.y) * ALPHA + a0[3]);
                    o.z = pk2(bflo(hh.z) * ALPHA + a1[0], bfhi(hh.z) * ALPHA + a1[1]); o.w = pk2(bflo(hh.w) * ALPHA + a1[2], bfhi(hh.w) * ALPHA + a1[3]);
                    *(u32x4*)(rbf + row * DM + c) = o; } }
    }
};
struct EpiGate {
    static constexpr bool PERM = true, AFTER_DRAIN = false;
    const float* bias; const bf16_t* ple; const bf16_t* rbf; bf16_t* ybf;
    __device__ __forceinline__ void operator()(const f32x4 (&acc)[2][2][4][2], const pg8::Unit& u, int wr, int wc, int fr, int fq) const {
        const int row0 = u.pm * 256 + wr * 64 + fr, col0 = u.pn * 256 + wc * 32 + 8 * fq;
#pragma unroll
        for (int bj = 0; bj < 2; ++bj) { const int c = col0 + bj * 128;
            const f32x4 b0 = *(const f32x4*)(bias + c), b1 = *(const f32x4*)(bias + c + 4);
#pragma unroll
            for (int ai = 0; ai < 2; ++ai)
#pragma unroll
                for (int m = 0; m < 4; ++m) { const size_t row = (size_t)(row0 + ai * 128 + m * 16);
                    const u32x4 rr = *(const u32x4*)(rbf + row * DM + c);
                    const u32x4 pl = *(const u32x4*)(ple + row * DM + c);
                    const f32x4 z0 = acc[ai][bj][m][0] + b0, z1 = acc[ai][bj][m][1] + b1;
                    const float y0 = bflo(rr.x) + sigmoidf_(z0[0]) * bflo(pl.x), y1 = bfhi(rr.x) + sigmoidf_(z0[1]) * bfhi(pl.x);
                    const float y2 = bflo(rr.y) + sigmoidf_(z0[2]) * bflo(pl.y), y3 = bfhi(rr.y) + sigmoidf_(z0[3]) * bfhi(pl.y);
                    const float y4 = bflo(rr.z) + sigmoidf_(z1[0]) * bflo(pl.z), y5 = bfhi(rr.z) + sigmoidf_(z1[1]) * bfhi(pl.z);
                    const float y6 = bflo(rr.w) + sigmoidf_(z1[2]) * bflo(pl.w), y7 = bfhi(rr.w) + sigmoidf_(z1[3]) * bfhi(pl.w);
                    u32x4 o; o.x = pk2(y0, y1); o.y = pk2(y2, y3); o.z = pk2(y4, y5); o.w = pk2(y6, y7);
                    *(u32x4*)(ybf + row * DM + c) = o; } }
    }
};

constexpr int KR_OFF = 0, VR_OFF = 9 * 64 * 128, XB_OFF = 2 * VR_OFF, REL_OFF = XB_OFF + 10 * 256 * 4;
constexpr float LOG2E = 1.4426950408889634f;
template <int NT, bool LKA, bool LKB>
__device__ __forceinline__ void attn_tiles(int slotA, int slotB, const bf16x8 q0, const bf16x8 q1, float bconst, const unsigned (&bzA)[8], const unsigned (&bzB)[8],
                                           PG8_LAS const unsigned char* kr, const unsigned (&koff)[2], PG8_LAS const unsigned char* vr, const unsigned (&voff)[4],
                                           float& m_run, float& sum, f32x4 (&o)[4]) {
    f32x4 st[NT * 4];
#pragma unroll
    for (int n = 0; n < NT; ++n) {
        PG8_LAS const unsigned char* kb_ = kr + (n == 0 ? slotA : slotB) * 8192;
#pragma unroll
        for (int ti = 0; ti < 4; ++ti) {
            const bf16x8 k0 = *(PG8_LAS const bf16x8*)(kb_ + ti * 2048 + koff[0]), k1 = *(PG8_LAS const bf16x8*)(kb_ + ti * 2048 + koff[1]);
            f32x4 z = {0.f, 0.f, 0.f, 0.f}; z = mfma16(k0, q0, z); z = mfma16(k1, q1, z); st[n * 4 + ti] = z;
        }
    }
    float mx = m_run;
#pragma unroll
    for (int n = 0; n < NT; ++n)
#pragma unroll
        for (int ti = 0; ti < 4; ++ti)
#pragma unroll
            for (int j = 0; j < 4; ++j) {
                float bias = bconst;
                if (n == 0 ? LKA : LKB) { const unsigned w = (n == 0 ? bzA : bzB)[ti * 2 + (j >> 1)]; bias = (j & 1) ? bfhi(w) : bflo(w); }
                const float sv = st[n * 4 + ti][j] * (0.125f * LOG2E) + bias;
                st[n * 4 + ti][j] = sv; mx = fmaxf(mx, sv);
            }
    mx = max_rows4(mx);
    const float sc = __builtin_amdgcn_exp2f(m_run - mx); m_run = mx;
    float ps = 0.f;
#pragma unroll
    for (int i = 0; i < NT * 4; ++i)
#pragma unroll
        for (int j = 0; j < 4; ++j) { const float pe = __builtin_amdgcn_exp2f(st[i][j] - mx); ps += pe; st[i][j] = pe; }
    sum = sum * sc + ps;
#pragma unroll
    for (int db = 0; db < 4; ++db) o[db] = o[db] * sc;
#pragma unroll
    for (int n = 0; n < NT; ++n) {
        PG8_LAS const unsigned char* sb = vr + (n == 0 ? slotA : slotB) * 8192;
#pragma unroll
        for (int kb = 0; kb < 2; ++kb) {
            const int t0 = n * 4 + 2 * kb;
            u32x4 pw; pw.x = pk2(st[t0][0], st[t0][1]); pw.y = pk2(st[t0][2], st[t0][3]); pw.z = pk2(st[t0 + 1][0], st[t0 + 1][1]); pw.w = pk2(st[t0 + 1][2], st[t0 + 1][3]);
            const bf16x8 pf = __builtin_bit_cast(bf16x8, pw);
#pragma unroll
            for (int db = 0; db < 4; ++db) {
                const s16x4 a0 = tr_read(sb + kb * 4096 + voff[db]), a1 = tr_read(sb + kb * 4096 + 2048 + voff[db]);
                o[db] = mfma16(__builtin_shufflevector(a0, a1, 0, 1, 2, 3, 4, 5, 6, 7), pf, o[db]);
            }
        }
    }
}
__device__ __forceinline__ void attn_unit(const bf16_t* __restrict__ proj, const float* __restrict__ rel_bias, bf16_t* __restrict__ mix, unsigned char* lds, int b, int h, int c_begin, int nsteps) {
    const int tid = opaque_tid(), wave = tid >> 6, lane = tid & 63, l15 = lane & 15, g = lane >> 4;
    PG8_LAS unsigned char* kr = (PG8_LAS unsigned char*)lds + KR_OFF;
    PG8_LAS unsigned char* vr = (PG8_LAS unsigned char*)lds + VR_OFF;
    float* xb = (float*)(lds + XB_OFF);
    float* rl = (float*)(lds + REL_OFF);
    const size_t brow = (size_t)b * SEQ;
    const int qg = wave & 3, kh = wave >> 2, qi = qg * 16 + l15;
    for (int i = tid; i < 257; i += NTHR) rl[i] = rel_bias[h * 257 + i] * LOG2E;
    const int skey = tid >> 3, sch = tid & 7;
    const unsigned kdst = (unsigned)(skey * 128 + ((sch ^ (skey & 7)) * 16));
    const unsigned vdst = (unsigned)(skey * 128 + ((sch ^ (((skey >> 1) & 3) << 1)) * 16));
    const bf16_t* ksrc = proj + (brow + skey) * NPROJ + C_AK + h * 64 + sch * 8;
    const bf16_t* vsrc = proj + (brow + skey) * NPROJ + C_AV + h * 64 + sch * 8;
#pragma unroll
    for (int k = 0; k < 8; ++k) {
        const int ac = c_begin - 8 + k;
        u32x4 kk = {0u, 0u, 0u, 0u}, vv = {0u, 0u, 0u, 0u};
        if (ac >= 0) { kk = *(const u32x4*)(ksrc + (size_t)ac * 64 * NPROJ); vv = *(const u32x4*)(vsrc + (size_t)ac * 64 * NPROJ); }
        const int slot = (ac + 9) % 9;
        *(PG8_LAS u32x4*)(kr + slot * 8192 + kdst) = kk; *(PG8_LAS u32x4*)(vr + slot * 8192 + vdst) = vv;
    }
    unsigned koff[2], voff[4];
#pragma unroll
    for (int ks = 0; ks < 2; ++ks) koff[ks] = (unsigned)(l15 * 128 + (((ks * 4 + g) ^ (l15 & 7)) * 16));
    { const int q = l15 >> 2, p = l15 & 3, sw = ((2 * g + (q >> 1)) & 3) << 1;
#pragma unroll
      for (int db = 0; db < 4; ++db) voff[db] = (unsigned)((4 * g + q) * 128 + (((2 * db + (p >> 1)) ^ sw) * 16) + (p & 1) * 8); }
    lds_barrier();
    unsigned bz[3][8];
#pragma unroll
    for (int bl = 0; bl < 3; ++bl)
#pragma unroll
        for (int ti = 0; ti < 4; ++ti)
#pragma unroll
            for (int jp = 0; jp < 2; ++jp) { int r0 = qi + 512 - ((6 + bl) * 64 + ti * 16 + 4 * g + 2 * jp); int r1 = r0 - 1; r0 = r0 > 128 ? 128 : r0; r1 = r1 > 128 ? 128 : r1; bz[bl][ti * 2 + jp] = pk2(rl[r0 + 128], rl[r1 + 128]); }
    const float bconst = rl[256];
    u32x4 pk = *(const u32x4*)(ksrc + (size_t)c_begin * 64 * NPROJ), pv = *(const u32x4*)(vsrc + (size_t)c_begin * 64 * NPROJ);
    size_t qrow = brow + (size_t)c_begin * 64 + qi;
    bf16x8 qf0 = *(const bf16x8*)(proj + qrow * NPROJ + C_AQ + h * 64 + g * 8), qf1 = *(const bf16x8*)(proj + qrow * NPROJ + C_AQ + h * 64 + 32 + g * 8);
    u32x2 gt[4];
#pragma unroll
    for (int db = 0; db < 4; ++db) gt[db] = *(const u32x2*)(proj + qrow * NPROJ + C_AG + h * 64 + db * 16 + 4 * g);
    const int c_end = c_begin + nsteps;
#pragma unroll 1
    for (int c = c_begin; c < c_end; ++c) {
        lds_barrier();
        { const int slot = c % 9; *(PG8_LAS u32x4*)(kr + slot * 8192 + kdst) = pk; *(PG8_LAS u32x4*)(vr + slot * 8192 + vdst) = pv; }
        const bf16x8 cq0 = qf0, cq1 = qf1; u32x2 cg[4];
#pragma unroll
        for (int db = 0; db < 4; ++db) cg[db] = gt[db];
        const size_t crow = qrow;
        if (c + 1 < c_end) {
            pk = *(const u32x4*)(ksrc + (size_t)(c + 1) * 64 * NPROJ); pv = *(const u32x4*)(vsrc + (size_t)(c + 1) * 64 * NPROJ);
            qrow += 64;
            qf0 = *(const bf16x8*)(proj + qrow * NPROJ + C_AQ + h * 64 + g * 8); qf1 = *(const bf16x8*)(proj + qrow * NPROJ + C_AQ + h * 64 + 32 + g * 8);
#pragma unroll
            for (int db = 0; db < 4; ++db) gt[db] = *(const u32x2*)(proj + qrow * NPROJ + C_AG + h * 64 + db * 16 + 4 * g);
        }
        lds_barrier();
        float m_run = -3.0e38f, sum = 0.f;
        f32x4 o[4];
#pragma unroll
        for (int db = 0; db < 4; ++db) o[db] = (f32x4){0.f, 0.f, 0.f, 0.f};
        const int nskip = 8 - c;
#define ATT1(LK, sl, bzz) attn_tiles<1, LK, false>((sl), 0, cq0, cq1, bconst, bzz, bzz, kr, koff, vr, voff, m_run, sum, o)
#define ATT2(LA, LB, sa, sb_, bza, bzb) attn_tiles<2, LA, LB>((sa), (sb_), cq0, cq1, bconst, bza, bzb, kr, koff, vr, voff, m_run, sum, o)
        if (kh == 0) {
            if (nskip <= 0) { ATT2(false, false, (c + 1) % 9, (c + 2) % 9, bz[0], bz[0]); ATT2(false, false, (c + 3) % 9, (c + 4) % 9, bz[0], bz[0]); ATT1(false, (c + 5) % 9, bz[0]); }
            else {
#pragma unroll 1
                for (int bc = 0; bc < 5; ++bc) if (bc >= nskip) ATT1(false, (c + 1 + bc) % 9, bz[0]);
            }
        } else {
            if (nskip <= 5) { ATT2(false, true, (c + 6) % 9, (c + 7) % 9, bz[0], bz[0]); ATT2(true, true, (c + 8) % 9, c % 9, bz[1], bz[2]); }
            else {
                if (6 >= nskip) ATT1(true, (c + 7) % 9, bz[0]);
                if (7 >= nskip) ATT1(true, (c + 8) % 9, bz[1]);
                ATT1(true, c % 9, bz[2]);
            }
            float* x = xb + qg * 64 + lane;
            x[0] = m_run; x[256] = sum;
#pragma unroll
            for (int db = 0; db < 4; ++db) { x[(2 + 2 * db) * 256] = __builtin_bit_cast(float, pk2(o[db][0], o[db][1])); x[(3 + 2 * db) * 256] = __builtin_bit_cast(float, pk2(o[db][2], o[db][3])); }
        }
        lds_barrier();
        if (kh == 0) {
            const float* x = xb + qg * 64 + lane;
            const float m1 = x[0], s1 = x[256];
            const float m = fmaxf(m_run, m1);
            const float a0 = __builtin_amdgcn_exp2f(m_run - m), a1 = __builtin_amdgcn_exp2f(m1 - m);
            float tot = sum * a0 + s1 * a1;
            tot = sum_rows4(tot);
            const float inv = __builtin_amdgcn_rcpf(tot);
#pragma unroll
            for (int db = 0; db < 4; ++db) {
                const unsigned w0 = __builtin_bit_cast(unsigned, x[(2 + 2 * db) * 256]), w1 = __builtin_bit_cast(unsigned, x[(3 + 2 * db) * 256]);
                const int d0 = db * 16 + 4 * g;
                const float v0 = (o[db][0] * a0 + bflo(w0) * a1) * inv * siluf_(bflo(cg[db].x)), v1 = (o[db][1] * a0 + bfhi(w0) * a1) * inv * siluf_(bfhi(cg[db].x));
                const float v2 = (o[db][2] * a0 + bflo(w1) * a1) * inv * siluf_(bflo(cg[db].y)), v3 = (o[db][3] * a0 + bfhi(w1) * a1) * inv * siluf_(bfhi(cg[db].y));
                u32x2 ov; ov.x = pk2(v0, v1); ov.y = pk2(v2, v3);
                *(u32x2*)(mix + crow * DM + h * 64 + d0) = ov;
            }
        }
    }
    lds_barrier();
}

constexpr int GS = 72;
constexpr int G2_GLR = 0, G2_SEG = 2048, G2_K = 3072, G2_Q = 11264, G2_V = 19456, G2_T = 35840, G2_BYTES = G2_T + 4 * 64 * GS * 2;
__device__ __forceinline__ void gla_gates(const unsigned char* base, const float (&w)[16], float bb, int tq, int d, float (&L)[16], float& Lend) {
    float* segtot = (float*)(base + G2_SEG);
    float run = 0.f;
#pragma unroll
    for (int i = 0; i < 16; ++i) {
        const unsigned char* gp = base + G2_GLR + (tq * 16 + i) * 32;
        const u32x4 a = *(const u32x4*)gp, b2 = *(const u32x4*)(gp + 16);
        float z = bb;
        z += bflo(a.x) * w[0] + bfhi(a.x) * w[1] + bflo(a.y) * w[2] + bfhi(a.y) * w[3] + bflo(a.z) * w[4] + bfhi(a.z) * w[5] + bflo(a.w) * w[6] + bfhi(a.w) * w[7];
        z += bflo(b2.x) * w[8] + bfhi(b2.x) * w[9] + bflo(b2.y) * w[10] + bfhi(b2.y) * w[11] + bflo(b2.z) * w[12] + bfhi(b2.z) * w[13] + bflo(b2.w) * w[14] + bfhi(b2.w) * w[15];
        const float ls = fminf(z, 0.f) - __logf(1.f + __expf(-fabsf(z)));
        run += ls * (1.f / 16.f); L[i] = run;
    }
    segtot[tq * 64 + d] = run;
    lds_barrier();
    float off = 0.f, tot = 0.f;
#pragma unroll
    for (int q = 0; q < 4; ++q) { const float v = segtot[q * 64 + d]; tot += v; if (q < tq) off += v; }
#pragma unroll
    for (int i = 0; i < 16; ++i) L[i] += off;
    Lend = tot;
}
#define GLA_ROW0(item) ((size_t)((item) >> 8) * SEQ + (size_t)(((item) >> 2) & 63) * 64)
__device__ __forceinline__ void gla_kv_phase(const Params& P, const bf16_t* __restrict__ proj, bf16_t* __restrict__ KV, float* __restrict__ DEC, bf16_t* __restrict__ EG, unsigned char* lds) {
    const int tid = opaque_tid(), wave = tid >> 6, lane = tid & 63, l15 = lane & 15, g = lane >> 4, grp = wave >> 2, w4 = wave & 3, tg = tid & 255;
    unsigned char* base = lds + grp * G2_BYTES;
    PG8_LAS const unsigned char* vl = (PG8_LAS const unsigned char*)base + G2_V;
    bf16_t* kendT = (bf16_t*)(base + G2_T);
    const int step = 2 * (int)gridDim.x;
    int item = blockIdx.x * 2 + grp;
    const int h = item & 3;
    float w[16];
#pragma unroll
    for (int r = 0; r < 16; ++r) w[r] = P.w_gla_gate[r * 256 + h * 64 + lane];
    const float bb = P.b_gla_gate[h * 64 + lane];
    const int kt_ = tg >> 3, kch = tg & 7, vs_ = tg >> 4, vch = tg & 15;
    unsigned voff[8];
    { const int q = l15 >> 2, p = l15 & 3, sw = (4 * (g & 1) + q) << 1;
#pragma unroll
      for (int vb = 0; vb < 8; ++vb) voff[vb] = (unsigned)((4 * g + q) * 256 + (((2 * vb + (p >> 1)) ^ sw) * 16) + (p & 1) * 8); }
    u32x4 pg = {0u, 0u, 0u, 0u}, pk[2], pv[4];
#define GLA_PF_KV(it_) do { const bf16_t* r0_ = proj + GLA_ROW0(it_) * NPROJ; \
        if (tg < 128) pg = *(const u32x4*)(r0_ + (size_t)(tg >> 1) * NPROJ + C_LR + (tg & 1) * 8); \
        _Pragma("unroll") for (int i_ = 0; i_ < 2; ++i_) pk[i_] = *(const u32x4*)(r0_ + (size_t)(kt_ + 32 * i_) * NPROJ + C_GK + h * 64 + kch * 8); \
        _Pragma("unroll") for (int i_ = 0; i_ < 4; ++i_) pv[i_] = *(const u32x4*)(r0_ + (size_t)(vs_ + 16 * i_) * NPROJ + C_GV + h * 128 + vch * 8); } while (0)
    GLA_PF_KV(item);
    for (; item < 2048; item += step) {
        lds_barrier();
        if (tg < 128) *(u32x4*)(base + G2_GLR + tg * 16) = pg;
#pragma unroll
        for (int i = 0; i < 2; ++i) *(u32x4*)(base + G2_K + (kt_ + 32 * i) * 128 + kch * 16) = pk[i];
#pragma unroll
        for (int i = 0; i < 4; ++i) { const int sr = vs_ + 16 * i; *(u32x4*)(base + G2_V + sr * 256 + ((vch ^ ((sr & 7) << 1)) * 16)) = pv[i]; }
        const int cur = item;
        if (item + step < 2048) GLA_PF_KV(item + step);
        lds_barrier();
        float L[16], Lend;
        gla_gates(base, w, bb, w4, lane, L, Lend);
#pragma unroll
        for (int i = 0; i < 16; ++i) { const int t = w4 * 16 + i;
            const float kv = bf2f(*(const bf16_t*)(base + G2_K + t * 128 + lane * 2));
            kendT[lane * GS + t] = (bf16_t)f2bf(kv * __expf(Lend - L[i]));
            EG[(size_t)cur * 4096 + t * 64 + lane] = (bf16_t)f2bf(__expf(L[i])); }
        const size_t sidx = (size_t)((cur >> 8) * 4 + h) * 64 + ((cur >> 2) & 63);
        if (w4 == 0) DEC[sidx * 64 + lane] = __expf(Lend);
        lds_barrier();
        bf16_t* kvo = KV + sidx * 8192;
#pragma unroll
        for (int vi = 0; vi < 2; ++vi) { const int vb = 2 * w4 + vi;
            bf16x8 af[2];
#pragma unroll
            for (int kb = 0; kb < 2; ++kb) { const s16x4 a0 = tr_read(vl + kb * 8192 + voff[vb]), a1 = tr_read(vl + kb * 8192 + 4096 + voff[vb]); af[kb] = __builtin_shufflevector(a0, a1, 0, 1, 2, 3, 4, 5, 6, 7); }
#pragma unroll
            for (int db = 0; db < 4; ++db) {
                f32x4 acc = {0.f, 0.f, 0.f, 0.f};
#pragma unroll
                for (int kb = 0; kb < 2; ++kb) {
                    const bf16_t* bp = kendT + (db * 16 + l15) * GS + kb * 32 + 4 * g;
                    const u32x2 b0 = *(const u32x2*)bp, b1 = *(const u32x2*)(bp + 16);
                    u32x4 bw; bw.x = b0.x; bw.y = b0.y; bw.z = b1.x; bw.w = b1.y;
                    acc = mfma16(__builtin_bit_cast(bf16x8, bw), af[kb], acc);
                }
                u32x2 ov; ov.x = pk2(acc[0], acc[1]); ov.y = pk2(acc[2], acc[3]);
                *(u32x2*)(kvo + (vb * 16 + l15) * 64 + db * 16 + 4 * g) = ov;
            } }
    }
    lds_barrier();
#undef GLA_PF_KV
}
constexpr int G3_V = 0, G3_T = 16384, G3_BYTES = G3_T + 4 * 64 * GS * 2;
__device__ __forceinline__ void gla_out_phase(const Params& P, const bf16_t* __restrict__ proj, const bf16_t* __restrict__ SP, const bf16_t* __restrict__ EG, bf16_t* __restrict__ mix, unsigned char* lds) {
    const int tid = opaque_tid(), wave = tid >> 6, lane = tid & 63, l15 = lane & 15, g = lane >> 4, grp = wave >> 2, w4 = wave & 3, tg = tid & 255;
    unsigned char* base = lds + grp * G3_BYTES;
    PG8_LAS const unsigned char* vl = (PG8_LAS const unsigned char*)base + G3_V;
    bf16_t* qfw = (bf16_t*)(base + G3_T); bf16_t* qbw = qfw + 64 * GS; bf16_t* kng = qbw + 64 * GS; bf16_t* kps = kng + 64 * GS;
    const int step = 2 * (int)gridDim.x;
    int item = blockIdx.x * 2 + grp;
    const int h = item & 3;
    const int kt_ = tg >> 3, kch = tg & 7, vs_ = tg >> 4, vch = tg & 15;
    unsigned voff[8];
    { const int q = l15 >> 2, p = l15 & 3, sw = (4 * (g & 1) + q) << 1;
#pragma unroll
      for (int vb = 0; vb < 8; ++vb) voff[vb] = (unsigned)((4 * g + q) * 256 + (((2 * vb + (p >> 1)) ^ sw) * 16) + (p & 1) * 8); }
    const int tb = w4, tl = tb * 16 + l15;
    u32x4 pk[2], pq[2], pe[2], pv[4];
#define GLA_PF_OUT(it_) do { const bf16_t* r0_ = proj + GLA_ROW0(it_) * NPROJ; const bf16_t* e0_ = EG + (size_t)(it_) * 4096; \
        _Pragma("unroll") for (int i_ = 0; i_ < 2; ++i_) { pk[i_] = *(const u32x4*)(r0_ + (size_t)(kt_ + 32 * i_) * NPROJ + C_GK + h * 64 + kch * 8); \
                                                          pq[i_] = *(const u32x4*)(r0_ + (size_t)(kt_ + 32 * i_) * NPROJ + C_GQ + h * 64 + kch * 8); \
                                                          pe[i_] = *(const u32x4*)(e0_ + (kt_ + 32 * i_) * 64 + kch * 8); } \
        _Pragma("unroll") for (int i_ = 0; i_ < 4; ++i_) pv[i_] = *(const u32x4*)(r0_ + (size_t)(vs_ + 16 * i_) * NPROJ + C_GV + h * 128 + vch * 8); } while (0)
    GLA_PF_OUT(item);
    for (; item < 2048; item += step) {
        lds_barrier();
#pragma unroll
        for (int i = 0; i < 2; ++i) {
            u32x4 wf, wb, wn, wp;
#pragma unroll
            for (int c2 = 0; c2 < 4; ++c2) {
                const unsigned qq = pq[i][c2], kk = pk[i][c2], ee = pe[i][c2];
                const float e0 = bflo(ee), e1 = bfhi(ee), r0 = __builtin_amdgcn_rcpf(e0), r1 = __builtin_amdgcn_rcpf(e1);
                const float q0 = bflo(qq) * 0.125f, q1 = bfhi(qq) * 0.125f, k0 = bflo(kk), k1 = bfhi(kk);
                wf[c2] = pk2(q0 * e0, q1 * e1); wb[c2] = pk2(q0 * r0, q1 * r1); wn[c2] = pk2(k0 * r0, k1 * r1); wp[c2] = pk2(k0 * e0, k1 * e1);
            }
            const int off = (kt_ + 32 * i) * GS + kch * 8;
            *(u32x4*)(qfw + off) = wf; *(u32x4*)(qbw + off) = wb; *(u32x4*)(kng + off) = wn; *(u32x4*)(kps + off) = wp;
        }
#pragma unroll
        for (int i = 0; i < 4; ++i) { const int sr = vs_ + 16 * i; *(u32x4*)(base + G3_V + sr * 256 + ((vch ^ ((sr & 7) << 1)) * 16)) = pv[i]; }
        const int cur = item;
        if (item + step < 2048) GLA_PF_OUT(item + step);
        const size_t row0 = GLA_ROW0(cur);
        const size_t trow = row0 + tl;
        const bf16_t* sp = SP + ((size_t)((cur >> 8) * 4 + h) * 64 + ((cur >> 2) & 63)) * 8192;
        u32x2 gt[8]; f32x4 gnv[8];
#pragma unroll
        for (int vb = 0; vb < 8; ++vb) { gt[vb] = *(const u32x2*)(proj + trow * NPROJ + C_GG + h * 128 + vb * 16 + 4 * g); gnv[vb] = *(const f32x4*)(P.gla_norm_g + h * 128 + vb * 16 + 4 * g); }
        lds_barrier();
        bf16x8 sf[8][2];
#pragma unroll
        for (int vb = 0; vb < 8; ++vb)
#pragma unroll
            for (int ks = 0; ks < 2; ++ks) sf[vb][ks] = *(const bf16x8*)(sp + (vb * 16 + l15) * 64 + ks * 32 + g * 8);
        bf16x8 qF[2], qB[2];
#pragma unroll
        for (int ks = 0; ks < 2; ++ks) { qF[ks] = *(const bf16x8*)(qfw + tl * GS + ks * 32 + g * 8); qB[ks] = *(const bf16x8*)(qbw + tl * GS + ks * 32 + g * 8); }
        f32x4 o[8];
#pragma unroll
        for (int vb = 0; vb < 8; ++vb) o[vb] = (f32x4){0.f, 0.f, 0.f, 0.f};
        f32x4 at[4];
#pragma unroll
        for (int sb = 0; sb < 4; ++sb) {
            const bf16_t* kn = kng + (sb * 16 + l15) * GS + g * 8; const bf16_t* kp = kps + (sb * 16 + l15) * GS + g * 8;
            f32x4 ca = {0.f, 0.f, 0.f, 0.f}, an = {0.f, 0.f, 0.f, 0.f};
            ca = mfma16(*(const bf16x8*)kn, qF[0], ca); ca = mfma16(*(const bf16x8*)(kn + 32), qF[1], ca);
            an = mfma16(*(const bf16x8*)kp, qB[0], an); an = mfma16(*(const bf16x8*)(kp + 32), qB[1], an);
#pragma unroll
            for (int j = 0; j < 4; ++j) { const int sx = sb * 16 + 4 * g + j; at[sb][j] = (sx <= tl) ? ca[j] : an[j]; }
        }
#pragma unroll
        for (int kb = 0; kb < 2; ++kb) {
            u32x4 pw; pw.x = pk2(at[2 * kb][0], at[2 * kb][1]); pw.y = pk2(at[2 * kb][2], at[2 * kb][3]); pw.z = pk2(at[2 * kb + 1][0], at[2 * kb + 1][1]); pw.w = pk2(at[2 * kb + 1][2], at[2 * kb + 1][3]);
            const bf16x8 pf = __builtin_bit_cast(bf16x8, pw);
#pragma unroll
            for (int vb = 0; vb < 8; ++vb) {
                const s16x4 a0 = tr_read(vl + kb * 8192 + voff[vb]), a1 = tr_read(vl + kb * 8192 + 4096 + voff[vb]);
                o[vb] = mfma16(__builtin_shufflevector(a0, a1, 0, 1, 2, 3, 4, 5, 6, 7), pf, o[vb]);
            }
        }
#pragma unroll
        for (int vb = 0; vb < 8; ++vb) { o[vb] = mfma16(sf[vb][0], qF[0], o[vb]); o[vb] = mfma16(sf[vb][1], qF[1], o[vb]); }
        float ss = 0.f;
#pragma unroll
        for (int vb = 0; vb < 8; ++vb)
#pragma unroll
            for (int j = 0; j < 4; ++j) ss += o[vb][j] * o[vb][j];
        ss = sum_rows4(ss);
        const float rs = __builtin_amdgcn_rsqf(ss * (1.f / 128.f) + 1e-6f);
#pragma unroll
        for (int vb = 0; vb < 8; ++vb) {
            const int v0 = vb * 16 + 4 * g;
            const f32x4 gn = gnv[vb];
            const float y0 = o[vb][0] * rs * gn[0] * siluf_(bflo(gt[vb].x)), y1 = o[vb][1] * rs * gn[1] * siluf_(bfhi(gt[vb].x));
            const float y2 = o[vb][2] * rs * gn[2] * siluf_(bflo(gt[vb].y)), y3 = o[vb][3] * rs * gn[3] * siluf_(bfhi(gt[vb].y));
            u32x2 ov; ov.x = pk2(y0, y1); ov.y = pk2(y2, y3);
            *(u32x2*)(mix + trow * DM + 512 + h * 128 + v0) = ov;
        }
    }
    lds_barrier();
#undef GLA_PF_OUT
}

#define XB_TMO      128
#define XB_XCNT(j)  (256  + 64 * (j))
#define XB_XSUB(j)  (1280 + 64 * (j))
#define XB_XGEN(j)  (2304 + 64 * (j))
#define XB_TOP      3328
#define XB_TOPGEN   3392
#define XCD_BAR_WORDS 3456
#define XB_SPIN_CAP (1u << 18)
__device__ __forceinline__ unsigned xb_ld(unsigned* p)              { return __hip_atomic_load(p, __ATOMIC_RELAXED, __HIP_MEMORY_SCOPE_AGENT); }
__device__ __forceinline__ unsigned xb_add(unsigned* p, unsigned v) { return __hip_atomic_fetch_add(p, v, __ATOMIC_RELAXED, __HIP_MEMORY_SCOPE_AGENT); }
__device__ __forceinline__ unsigned xb_xcc_id() { return (unsigned)__builtin_amdgcn_s_getreg((3 << 11) | 20) & 0xFu; }
#define XB_SPIN(cond, bar) do { unsigned _sp = 0; while (cond) { __builtin_amdgcn_s_sleep(1); \
    if ((++_sp & 255u) == 0u) { if (xb_ld(&(bar)[XB_TMO])) break; if (_sp > XB_SPIN_CAP) { atomicAdd(&(bar)[XB_TMO], 1u); break; } } } } while (0)
struct XcdBarrier { unsigned* bar; unsigned x; volatile PG8_LAS unsigned* st; };
__device__ __forceinline__ XcdBarrier xcd_barrier_post(unsigned* bar, volatile PG8_LAS unsigned* st) {
    XcdBarrier b; b.bar = bar; b.x = xb_xcc_id(); b.st = st;
    if (threadIdx.x == 0) (void)xb_add(&bar[XB_XCNT(b.x)], 1u);
    return b;
}
__device__ __forceinline__ void xcd_barrier_complete(unsigned* bar, unsigned x, unsigned& nloc, unsigned& nx) {
    const unsigned G = gridDim.x * gridDim.y * gridDim.z;
    unsigned sum, cnt, mine, sp = 0u;
    for (;;) {
        sum = 0u; cnt = 0u; mine = 0u;
#pragma unroll
        for (unsigned j = 0; j < 16; ++j) { const unsigned c = xb_ld(&bar[XB_XCNT(j)]); sum += c; cnt += (c > 0u) ? 1u : 0u; mine = (j == x) ? c : mine; }
        if (sum == G) break;
        __builtin_amdgcn_s_sleep(1);
        if ((++sp & 255u) == 0u) { if (xb_ld(&bar[XB_TMO])) break; if (sp > XB_SPIN_CAP) { atomicAdd(&bar[XB_TMO], 1u); break; } }
    }
    nloc = mine > 0u ? mine : 1u; nx = cnt > 0u ? cnt : 1u;
}
__device__ __forceinline__ void xcd_barrier(const XcdBarrier& b) {
    asm volatile("s_waitcnt vmcnt(0)" ::: "memory");
    __syncthreads();
    if (threadIdx.x == 0) {
        unsigned* bar = b.bar;
        __builtin_amdgcn_s_waitcnt(0);
        unsigned nloc = b.st[0], nx = b.st[1];
        if (nloc == 0u) { xcd_barrier_complete(bar, b.x, nloc, nx); b.st[0] = nloc; b.st[1] = nx; }
        const unsigned old = xb_add(&bar[XB_XSUB(b.x)], 1u);
        const unsigned gen = old / nloc;
        if (old + 1u == (gen + 1u) * nloc) {
            __builtin_amdgcn_fence(__ATOMIC_RELEASE, "agent");
            asm volatile("s_waitcnt vmcnt(0)" ::: "memory");
            const unsigned og = xb_add(&bar[XB_TOP], 1u);
            const unsigned tg = og / nx;
            if (og + 1u == (tg + 1u) * nx) xb_add(&bar[XB_TOPGEN], 1u);
            else XB_SPIN(xb_ld(&bar[XB_TOPGEN]) == tg, bar);
            __builtin_amdgcn_fence(__ATOMIC_ACQUIRE, "agent");
            xb_add(&bar[XB_XGEN(b.x)], 1u);
            asm volatile("s_waitcnt vmcnt(0)" ::: "memory");
        } else {
            XB_SPIN(xb_ld(&bar[XB_XGEN(b.x)]) == gen, bar);
            __builtin_amdgcn_fence(__ATOMIC_ACQUIRE, "agent");
            asm volatile("s_waitcnt vmcnt(0)" ::: "memory");
        }
    }
    __syncthreads();
}

__global__ void __launch_bounds__(NTHR, 2) fwd_megakernel(Params P) {
    extern __shared__ __attribute__((aligned(16))) unsigned char lds[];
    cg::grid_group grid = cg::this_grid();
    const int tid = threadIdx.x, wave = tid >> 6, lane = tid & 63;
    unsigned char* ws = P.ws;
    bf16_t* proj = (bf16_t*)(ws + WS_PROJ); bf16_t* mix = (bf16_t*)(ws + WS_MIX); bf16_t* KVB = (bf16_t*)(ws + WS_KV); float* DEC = (float*)(ws + WS_DEC);
    const int G = gridDim.x;
    { volatile PG8_LAS unsigned* z = (volatile PG8_LAS unsigned*)((PG8_LAS unsigned char*)lds + LDS_BYTES - 16); if (tid < 4) z[tid] = 0u; }
    __syncthreads();
    const XcdBarrier xbar = xcd_barrier_post((unsigned*)(ws + WS_BAR), (volatile PG8_LAS unsigned*)((PG8_LAS unsigned char*)lds + LDS_BYTES - 16));
    if (P.ws == nullptr) grid.sync();

    prep_phase(P, lds);
    xcd_barrier(xbar);
    {
        pg8::Gemm gm{(const bf16_t*)(ws + WS_HBF), (const bf16_t*)(ws + WS_WIN), T_TOK, 3584, DM}; pg8::StaticOrder S; S.init(T_TOK, 3584, G, (int)blockIdx.x);
        EpiBf16 E{proj, NPROJ, NPROJ};
        pg8::gemm_phase<EpiBf16, pg8::StaticOrder, true, true>((PG8_LAS unsigned char*)lds, gm, S, E);
    }
    {
        const int lane_ = tid & 63, l15 = lane_ & 15, g4 = lane_ >> 4;
        const bf16_t* hb = (const bf16_t*)(ws + WS_HBF); const bf16_t* wl = (const bf16_t*)(ws + WS_WIN) + (size_t)3584 * DM;
        for (int rg = blockIdx.x * NWAVES + (tid >> 6); rg < T_TOK / 16; rg += G * NWAVES) {
            const bf16_t* ap = hb + (size_t)(rg * 16 + l15) * DM + g4 * 8; const bf16_t* bp = wl + (size_t)l15 * DM + g4 * 8;
            f32x4 acc0 = {0.f, 0.f, 0.f, 0.f}, acc1 = {0.f, 0.f, 0.f, 0.f};
#pragma unroll 8
            for (int ks = 0; ks < 32; ks += 2) {
                acc0 = mfma16(*(const bf16x8*)(bp + ks * 32), *(const bf16x8*)(ap + ks * 32), acc0);
                acc1 = mfma16(*(const bf16x8*)(bp + ks * 32 + 32), *(const bf16x8*)(ap + ks * 32 + 32), acc1);
            }
            const f32x4 r = acc0 + acc1;
            u32x2 o; o.x = pk2(r[0], r[1]); o.y = pk2(r[2], r[3]);
            *(u32x2*)(proj + (size_t)(rg * 16 + l15) * NPROJ + C_LR + 4 * g4) = o;
        }
    }
    xcd_barrier(xbar);
#ifndef NO_ATTN
    for (int rep = 0; rep < DUP_ATTN; ++rep)
    for (int u0 = blockIdx.x; u0 < 256; u0 += G) { const int u = (G == 256) ? ((u0 & 7) * 32 + (u0 >> 3)) : u0;
        attn_unit(proj, P.rel_bias, mix, lds, u >> 5, (u >> 2) & 7, (u & 3) * 16, 16); }
#endif
    for (int rep = 0; rep < DUP_KV; ++rep) gla_kv_phase(P, proj, KVB, DEC, (bf16_t*)(ws + WS_EG), lds);
    xcd_barrier(xbar);
#ifndef DUP_SCAN
#define DUP_SCAN 1
#endif
    for (int rep = 0; rep < DUP_SCAN; ++rep)
    for (int e = blockIdx.x * NTHR + tid; e < 32 * 2048; e += G * NTHR) {
        const int bh = e >> 11, vd = (e & 2047) * 4, d = vd & 63;
        const bf16_t* __restrict__ kvp = KVB + (size_t)bh * 64 * 8192 + vd; const float* __restrict__ dp = DEC + (size_t)bh * 64 * 64 + d;
        bf16_t* __restrict__ spo = (bf16_t*)(ws + WS_SPREV) + (size_t)bh * 64 * 8192 + vd;
        f32x4 stt = {0.f, 0.f, 0.f, 0.f};
#pragma unroll 1
        for (int c0 = 0; c0 < 64; c0 += 8) {
            u32x2 kv[8]; f32x4 dc[8];
#pragma unroll
            for (int u = 0; u < 8; ++u) { kv[u] = *(const u32x2*)(kvp + (size_t)(c0 + u) * 8192); dc[u] = *(const f32x4*)(dp + (c0 + u) * 64); }
#pragma unroll
            for (int u = 0; u < 8; ++u) { u32x2 o; o.x = pk2(stt[0], stt[1]); o.y = pk2(stt[2], stt[3]); *(u32x2*)(spo + (size_t)(c0 + u) * 8192) = o;
                const f32x4 kf = {bflo(kv[u].x), bfhi(kv[u].x), bflo(kv[u].y), bfhi(kv[u].y)}; stt = dc[u] * stt + kf; }
        }
    }
    xcd_barrier(xbar);
    for (int rep = 0; rep < DUP_OUT; ++rep) gla_out_phase(P, proj, (const bf16_t*)(ws + WS_SPREV), (const bf16_t*)(ws + WS_EG), mix, lds);
    xcd_barrier(xbar);
    {
        pg8::Gemm gm{mix, (const bf16_t*)(ws + WS_WOUT), T_TOK, DM, DM}; pg8::StaticOrder S; S.init(T_TOK, DM, G, (int)blockIdx.x);
        EpiRes E{(const bf16_t*)(ws + WS_HBF), (bf16_t*)(ws + WS_R32)};
        pg8::gemm_phase<EpiRes, pg8::StaticOrder, true, true>((PG8_LAS unsigned char*)lds, gm, S, E);
    }
    {
        pg8::Gemm gm{(const bf16_t*)(ws + WS_PBF), (const bf16_t*)(ws + WS_WP), T_TOK, DM, DPLE}; pg8::StaticOrder S; S.init(T_TOK, DM, G, (int)blockIdx.x);
        EpiBf16 E{proj, DM, DM};
        pg8::gemm_phase<EpiBf16, pg8::StaticOrder, true, true>((PG8_LAS unsigned char*)lds, gm, S, E);
    }
    xcd_barrier(xbar);
    {
        pg8::Gemm gm{(const bf16_t*)(ws + WS_R32), (const bf16_t*)(ws + WS_WG), T_TOK, DM, DM}; pg8::StaticOrder S; S.init(T_TOK, DM, G, (int)blockIdx.x);
        EpiGate E{P.b_ple_gate, proj, (const bf16_t*)(ws + WS_R32), (bf16_t*)(ws + WS_KV)};
        pg8::gemm_phase<EpiGate, pg8::StaticOrder, true, true>((PG8_LAS unsigned char*)lds, gm, S, E);
    }
    xcd_barrier(xbar);
    {
        const bf16_t* ybf = (const bf16_t*)(ws + WS_KV);
        f32x4 gg[4], bb[4];
#pragma unroll
        for (int j = 0; j < 4; ++j) { gg[j] = ((const f32x4*)P.ln_g)[lane + 64 * j]; bb[j] = ((const f32x4*)P.ln_b)[lane + 64 * j]; }
        for (int m = blockIdx.x * NWAVES + wave; m < T_TOK; m += 2 * G * NWAVES) {
            const int m2 = m + G * NWAVES;
            const bool has2 = m2 < T_TOK;
            const u32x2* yr = (const u32x2*)(ybf + (size_t)m * DM) + lane;
            const u32x2* yr2 = (const u32x2*)(ybf + (size_t)(has2 ? m2 : m) * DM) + lane;
            u32x2 t[4], t2[4];
#pragma unroll
            for (int j = 0; j < 4; ++j) { t[j] = yr[64 * j]; t2[j] = yr2[64 * j]; }
            f32x4 v[4], w[4]; float s = 0.f, sb = 0.f;
#pragma unroll
            for (int j = 0; j < 4; ++j) { v[j] = (f32x4){bflo(t[j].x), bfhi(t[j].x), bflo(t[j].y), bfhi(t[j].y)}; s += (v[j].x + v[j].y) + (v[j].z + v[j].w);
                                          w[j] = (f32x4){bflo(t2[j].x), bfhi(t2[j].x), bflo(t2[j].y), bfhi(t2[j].y)}; sb += (w[j].x + w[j].y) + (w[j].z + w[j].w); }
            const float mean = wave_sum(s) * (1.f / DM), meanb = wave_sum(sb) * (1.f / DM); float s2 = 0.f, s2b = 0.f;
#pragma unroll
            for (int j = 0; j < 4; ++j) { v[j] = v[j] - mean; s2 += (v[j].x * v[j].x + v[j].y * v[j].y) + (v[j].z * v[j].z + v[j].w * v[j].w);
                                          w[j] = w[j] - meanb; s2b += (w[j].x * w[j].x + w[j].y * w[j].y) + (w[j].z * w[j].z + w[j].w * w[j].w); }
            const float rstd = __builtin_amdgcn_rsqf(wave_sum(s2) * (1.f / DM) + 1e-5f), rstdb = __builtin_amdgcn_rsqf(wave_sum(s2b) * (1.f / DM) + 1e-5f);
            f32x4* orow = (f32x4*)(P.out + (size_t)m * DM) + lane;
#pragma unroll
            for (int j = 0; j < 4; ++j) orow[64 * j] = v[j] * rstd * gg[j] + bb[j];
            if (has2) { f32x4* orow2 = (f32x4*)(P.out + (size_t)m2 * DM) + lane;
#pragma unroll
                for (int j = 0; j < 4; ++j) orow2[64 * j] = w[j] * rstdb * gg[j] + bb[j]; }
        }
    }
}

extern "C" void kernel_launch(void* const* d_in, const int* in_sizes, int n_in, void* d_out, int out_size, void* d_ws, size_t ws_size, hipStream_t stream) {
    static int grid_blocks = 0;
    if (grid_blocks == 0) {
        if (n_in != 15 || out_size != T_TOK * DM || ws_size < WS_END) { fprintf(stderr, "kernel_launch: unexpected shapes (n_in %d out %d ws %zu need %zu)\n", n_in, out_size, ws_size, (size_t)WS_END); grid_blocks = -1; return; }
        int dev = 0, cus = 0, per_cu = 0;
        hipGetDevice(&dev); hipDeviceGetAttribute(&cus, hipDeviceAttributeMultiprocessorCount, dev);
        if (hipFuncSetAttribute((const void*)fwd_megakernel, hipFuncAttributeMaxDynamicSharedMemorySize, LDS_BYTES) != hipSuccess) { fprintf(stderr, "kernel_launch: hipFuncSetAttribute failed\n"); grid_blocks = -1; return; }
        if (hipOccupancyMaxActiveBlocksPerMultiprocessor(&per_cu, (const void*)fwd_megakernel, NTHR, LDS_BYTES) != hipSuccess || per_cu < 1) { fprintf(stderr, "kernel_launch: occupancy query gave %d\n", per_cu); per_cu = 1; }
        (void)hipGetLastError();
        grid_blocks = cus;
    }
    if (grid_blocks < 0) return;
    Params P{};
    P.x = (const float*)d_in[0]; P.p = (const float*)d_in[1]; P.ln_in_g = (const float*)d_in[2]; P.ln_in_b = (const float*)d_in[3]; P.w_in = (const float*)d_in[4];
    P.w_gla_gate = (const float*)d_in[5]; P.b_gla_gate = (const float*)d_in[6]; P.rel_bias = (const float*)d_in[7]; P.gla_norm_g = (const float*)d_in[8];
    P.w_out = (const float*)d_in[9]; P.w_ple = (const float*)d_in[10]; P.w_ple_gate = (const float*)d_in[11]; P.b_ple_gate = (const float*)d_in[12];
    P.ln_g = (const float*)d_in[13]; P.ln_b = (const float*)d_in[14]; P.out = (float*)d_out; P.ws = (unsigned char*)d_ws;
    if (hipMemsetAsync((unsigned char*)d_ws + WS_BAR, 0, 16384, stream) != hipSuccess) { fprintf(stderr, "kernel_launch: memset failed\n"); return; }
    void* args[] = {&P};
    hipError_t e = hipLaunchCooperativeKernel((const void*)fwd_megakernel, dim3(grid_blocks), dim3(NTHR), args, LDS_BYTES, stream);
    if (e != hipSuccess) fprintf(stderr, "cooperative launch failed: %s (grid %d)\n", hipGetErrorString(e), grid_blocks);
}
```

```cpp
#include <hip/hip_runtime.h>
#include <hip/hip_cooperative_groups.h>
#include <cstdio>
#include <cstdint>
namespace cg = cooperative_groups;
#ifndef DUP_ATTN
#define DUP_ATTN 1
#endif
#ifndef DUP_KV
#define DUP_KV 1
#endif
#ifndef DUP_OUT
#define DUP_OUT 1
#endif
#ifndef DUP_G1
#define DUP_G1 1
#endif
__device__ __forceinline__ int opaque_tid_g() { int t = threadIdx.x; asm volatile("" : "+v"(t)); return t; }
namespace pg8 {
#define PG8_LAS __attribute__((address_space(3)))
typedef unsigned short bf16_t;
typedef short bf16x8 __attribute__((ext_vector_type(8)));
typedef float f32x4 __attribute__((ext_vector_type(4)));
typedef unsigned u32x4 __attribute__((ext_vector_type(4)));
constexpr int BM = 256, BK = 64, HALF = 128, HTB = HALF * BK * 2  , STAGE_BYTES = 8 * HTB, NXCD = 8, WGM = 8;

__host__ __device__ __forceinline__ int lds_byte(int r, int c) { const int st = (r >> 4) * 2 + (c >> 5), rr = r & 15, cc = c & 31, ob = rr * 64 + cc * 2; return st * 1024 + (ob ^ (((ob >> 9) & 1) << 5)); }
__host__ __device__ __forceinline__ void stage_rc(int b, int& R, int& C) { const int st = b / 1024, sb = b % 1024, swz = sb ^ (((sb >> 9) & 1) << 5); R = (st >> 1) * 16 + swz / 64; C = (st & 1) * 32 + (swz % 64) / 2; }
__host__ __device__ __forceinline__ int perm32(int rho) { const int n = rho >> 4, i = rho & 15; return 8 * (i >> 2) + 4 * n + (i & 3); }

struct Unit { int pm, pn; };
struct Gemm { const bf16_t* A; const bf16_t* Bt; int M, N, K; };

struct StaticOrder {
    int nM, nN, nwg, G, c;
    __host__ __device__ void init(int M, int N, int G_, int c_) { nM = M / BM; nN = N / BM; nwg = nM * nN; G = G_; c = c_; }
    __host__ __device__ bool next(int i, Unit& u) const {
        const long L = (long)i * G + c; if (L >= nwg) return false;
        int wgid = (int)L; { const int q = nwg / NXCD, r = nwg % NXCD, xcd = wgid % NXCD, off = wgid / NXCD; wgid = (xcd < r ? xcd * (q + 1) : r * (q + 1) + (xcd - r) * q) + off; }
        const int nig = WGM * nN, gid = wgid / nig, fm = gid * WGM, gsz = (nM - fm) < WGM ? (nM - fm) : WGM;
        u.pm = fm + ((wgid % nig) % gsz); u.pn = (wgid % nig) / gsz; return true;
    }
    __device__ __forceinline__ void a_ready(const Unit&) const {}
    __device__ __forceinline__ void done(const Unit&) const {}
};

template <class Epi, class Sched, bool ALIGN_EPI = false, bool SP2 = false>
__device__ __forceinline__ void gemm_phase(PG8_LAS unsigned char* lds, const Gemm g, const Sched& S, const Epi& E) {
    const int tid = opaque_tid_g(), wid = __builtin_amdgcn_readfirstlane(tid >> 6), lane = tid & 63, wr = wid >> 2, wc = wid & 3, fr = lane & 15, fq = lane >> 4;
    const int K = g.K, nt = K / BK;
    unsigned voffA[2], voffB[2];
#pragma unroll
    for (int i = 0; i < 2; ++i) { int R, C; stage_rc(tid * 16 + i * 8192, R, C); const int Rb = Epi::PERM ? ((R & ~31) + perm32(R & 31)) : R;
        voffA[i] = (unsigned)(R * K + C) * 2u; voffB[i] = (unsigned)(Rb * K + C) * 2u; }
    const size_t kstep = (size_t)(BK * 2);
    const size_t hstep = (size_t)HALF * K * 2;
    const size_t tstep = 2 * hstep;
    const unsigned ldsw = (unsigned)wid * 1024u;
    const int aoff = lds_byte(wr * 64 + fr, fq * 8), boff = lds_byte(wc * 32 + fr, fq * 8);
#define PG8_SA(b, h) (((b) * 2 + (h)) * HTB)
#define PG8_SB(b, h) ((4 + (b) * 2 + (h)) * HTB)
#define PG8_STAGE(bufoff, gbase, voff) do { _Pragma("unroll") for (int _i = 0; _i < 2; ++_i) \
        __builtin_amdgcn_global_load_lds((const unsigned*)((const char*)(gbase) + (voff)[_i]), (PG8_LAS unsigned*)(lds + (bufoff) + ldsw + _i * 8192), 16, 0, 0); } while (0)
#define PG8_LDA(dst, b, h) do { _Pragma("unroll") for (int m = 0; m < 4; ++m) _Pragma("unroll") for (int k = 0; k < 2; ++k) dst[m][k] = *(const PG8_LAS bf16x8*)(lds + PG8_SA(b, h) + aoff + m * 2048 + k * 1024); } while (0)
#define PG8_LDB(dst, b, h) do { _Pragma("unroll") for (int n = 0; n < 2; ++n) _Pragma("unroll") for (int k = 0; k < 2; ++k) dst[n][k] = *(const PG8_LAS bf16x8*)(lds + PG8_SB(b, h) + boff + n * 2048 + k * 1024); } while (0)
#define PG8_MMA(ai, bj, At, Bt) do { __builtin_amdgcn_s_setprio(1); _Pragma("unroll") for (int m = 0; m < 4; ++m) _Pragma("unroll") for (int n = 0; n < 2; ++n) _Pragma("unroll") for (int k = 0; k < 2; ++k) \
        acc[ai][bj][m][n] = __builtin_amdgcn_mfma_f32_16x16x32_bf16(Bt[n][k], At[m][k], acc[ai][bj][m][n], 0, 0, 0); __builtin_amdgcn_s_setprio(0); } while (0)
#define PG8_WAIT_V(n) asm volatile("s_waitcnt vmcnt(" #n ")" ::: "memory")
#define PG8_WAIT_L(n) asm volatile("s_waitcnt lgkmcnt(" #n ")" ::: "memory")
#define PG8_BAR __builtin_amdgcn_s_barrier()
#define PG8_SCHED __builtin_amdgcn_sched_barrier(0)
    Unit cur, nxt; int ui = 0;
    if (!S.next(0, cur)) return;
    f32x4 acc[2][2][4][2];
#pragma unroll
    for (int a = 0; a < 2; ++a)
#pragma unroll
        for (int b = 0; b < 2; ++b)
#pragma unroll
            for (int m = 0; m < 4; ++m)
#pragma unroll
                for (int n = 0; n < 2; ++n) acc[a][b][m][n] = (f32x4){0.f, 0.f, 0.f, 0.f};
    bf16x8 At[4][2], B0[2][2], B1[2][2];
    const char* cA = (const char*)g.A + (size_t)cur.pm * tstep; const char* cB = (const char*)g.Bt + (size_t)cur.pn * tstep;
    S.a_ready(cur);
    if constexpr (SP2) {
        PG8_STAGE(PG8_SB(0, 0), cB, voffB); PG8_STAGE(PG8_SB(0, 1), cB + hstep, voffB); PG8_STAGE(PG8_SA(0, 0), cA, voffA); PG8_STAGE(PG8_SA(0, 1), cA + hstep, voffA);
        if (wr == 1) PG8_BAR;
        PG8_WAIT_V(2); PG8_BAR;
        PG8_STAGE(PG8_SB(1, 0), cB + kstep, voffB); PG8_STAGE(PG8_SA(1, 0), cA + kstep, voffA); PG8_STAGE(PG8_SB(1, 1), cB + hstep + kstep, voffB);
        PG8_WAIT_V(6); PG8_BAR;
    } else {
        PG8_STAGE(PG8_SB(0, 0), cB, voffB); PG8_STAGE(PG8_SA(0, 0), cA, voffA); PG8_STAGE(PG8_SB(0, 1), cB + hstep, voffB); PG8_STAGE(PG8_SA(0, 1), cA + hstep, voffA);
        if (wr == 1) PG8_BAR;
        PG8_WAIT_V(4); PG8_BAR;
        PG8_STAGE(PG8_SB(1, 0), cB + kstep, voffB); PG8_STAGE(PG8_SA(1, 0), cA + kstep, voffA); PG8_STAGE(PG8_SB(1, 1), cB + hstep + kstep, voffB);
        PG8_WAIT_V(6); PG8_BAR;
    }
    for (;;) {
        const bool has_next = S.next(ui + 1, nxt);
        const char* nA = has_next ? (const char*)g.A + (size_t)nxt.pm * tstep : cA; const char* nB = has_next ? (const char*)g.Bt + (size_t)nxt.pn * tstep : cB;
        for (int t = 0; t < nt; t += 2) {
            const bool last = (t == nt - 2);
            const char* a1 = cA + (size_t)(t + 1) * kstep;
            const char* a2 = last ? nA : cA + (size_t)(t + 2) * kstep; const char* b2 = last ? nB : cB + (size_t)(t + 2) * kstep;
            const char* a3 = a2 + kstep; const char* b3 = b2 + kstep;
            if (last && has_next) S.a_ready(nxt);
            if constexpr (SP2) {
            PG8_LDB(B0, 0, 0); PG8_LDB(B1, 0, 1); PG8_SCHED; PG8_LDA(At, 0, 0); PG8_STAGE(PG8_SA(1, 1), a1 + hstep, voffA);
            PG8_WAIT_V(8); PG8_WAIT_L(0); PG8_BAR; PG8_MMA(0, 0, At, B0); PG8_MMA(0, 1, At, B1); PG8_BAR; PG8_SCHED;
            PG8_LDA(At, 0, 1); PG8_STAGE(PG8_SB(0, 0), b2, voffB); PG8_STAGE(PG8_SB(0, 1), b2 + hstep, voffB); PG8_STAGE(PG8_SA(0, 0), a2, voffA);
            PG8_WAIT_V(8); PG8_WAIT_L(0); PG8_BAR; PG8_MMA(1, 0, At, B0); PG8_MMA(1, 1, At, B1); PG8_BAR; PG8_SCHED;
            PG8_LDB(B0, 1, 0); PG8_LDB(B1, 1, 1); PG8_SCHED; PG8_LDA(At, 1, 0); PG8_STAGE(PG8_SA(0, 1), a2 + hstep, voffA);
            PG8_WAIT_V(8); PG8_WAIT_L(0); PG8_BAR; PG8_MMA(0, 0, At, B0); PG8_MMA(0, 1, At, B1); PG8_BAR; PG8_SCHED;
            PG8_LDA(At, 1, 1); PG8_STAGE(PG8_SB(1, 0), b3, voffB); PG8_STAGE(PG8_SB(1, 1), b3 + hstep, voffB); PG8_STAGE(PG8_SA(1, 0), a3, voffA);
            PG8_WAIT_V(8); PG8_WAIT_L(0); PG8_BAR; PG8_MMA(1, 0, At, B0); PG8_MMA(1, 1, At, B1); PG8_BAR; PG8_SCHED;
            } else {
            PG8_LDB(B0, 0, 0); PG8_SCHED; PG8_LDA(At, 0, 0); PG8_STAGE(PG8_SA(1, 1), a1 + hstep, voffA);
            PG8_WAIT_L(8); PG8_BAR; PG8_WAIT_L(0); PG8_MMA(0, 0, At, B0); PG8_BAR; PG8_SCHED;
            PG8_LDB(B1, 0, 1); PG8_STAGE(PG8_SB(0, 0), b2, voffB);
            PG8_BAR; PG8_WAIT_L(0); PG8_MMA(0, 1, At, B1); PG8_BAR;
            PG8_LDA(At, 0, 1); PG8_STAGE(PG8_SA(0, 0), a2, voffA);
            PG8_BAR; PG8_WAIT_L(0); PG8_MMA(1, 0, At, B0); PG8_BAR; PG8_SCHED;
            PG8_STAGE(PG8_SB(0, 1), b2 + hstep, voffB);
            PG8_WAIT_V(6); PG8_BAR; PG8_MMA(1, 1, At, B1); PG8_BAR;
            PG8_LDB(B0, 1, 0); PG8_SCHED; PG8_LDA(At, 1, 0); PG8_STAGE(PG8_SA(0, 1), a2 + hstep, voffA);
            PG8_WAIT_L(8); PG8_BAR; PG8_WAIT_L(0); PG8_MMA(0, 0, At, B0); PG8_BAR; PG8_SCHED;
            PG8_LDB(B1, 1, 1); PG8_STAGE(PG8_SB(1, 0), b3, voffB);
            PG8_BAR; PG8_WAIT_L(0); PG8_MMA(0, 1, At, B1); PG8_BAR;
            PG8_LDA(At, 1, 1); PG8_STAGE(PG8_SA(1, 0), a3, voffA);
            PG8_BAR; PG8_WAIT_L(0); PG8_MMA(1, 0, At, B0); PG8_BAR; PG8_SCHED;
            PG8_STAGE(PG8_SB(1, 1), b3 + hstep, voffB);
            PG8_WAIT_V(6); PG8_BAR; PG8_MMA(1, 1, At, B1); PG8_BAR;
            }
        }
        if constexpr (ALIGN_EPI) { if (wr == 0) PG8_BAR; }
        if constexpr (!Epi::AFTER_DRAIN) { E(acc, cur, wr, wc, fr, fq); S.done(cur); }
        if (!has_next) break;
#pragma unroll
        for (int a = 0; a < 2; ++a)
#pragma unroll
            for (int b = 0; b < 2; ++b)
#pragma unroll
                for (int m = 0; m < 4; ++m)
#pragma unroll
                    for (int n = 0; n < 2; ++n) acc[a][b][m][n] = (f32x4){0.f, 0.f, 0.f, 0.f};
        cur = nxt; cA = nA; cB = nB; ++ui;
        if constexpr (ALIGN_EPI) { if (wr == 1) PG8_BAR; }
    }
    PG8_WAIT_V(0);
    if constexpr (!ALIGN_EPI) { if (wr == 0) PG8_BAR; }
    PG8_BAR;
    if constexpr (Epi::AFTER_DRAIN) { E.fused(acc, cur, wr, wc, fr, fq, lds, wid, lane); S.done(cur); }
#undef PG8_SA
#undef PG8_SB
#undef PG8_STAGE
#undef PG8_LDA
#undef PG8_LDB
#undef PG8_MMA
#undef PG8_WAIT_V
#undef PG8_WAIT_L
#undef PG8_BAR
#undef PG8_SCHED
}
}

using pg8::bf16_t; using pg8::bf16x8; using pg8::f32x4; using pg8::u32x4;
typedef unsigned u32x2 __attribute__((ext_vector_type(2)));
constexpr int T_TOK = 32768, DM = 1024, SEQ = 4096, NPROJ = 3600, NPAD = 3840, DPLE = 256;
constexpr int C_AQ = 0, C_AK = 512, C_AV = 1024, C_AG = 1536, C_GQ = 2048, C_GK = 2304, C_GV = 2560, C_GG = 3072, C_LR = 3584;
constexpr float ALPHA = 1.189207115002721f;
constexpr int NTHR = 512, NWAVES = 8;
constexpr int LDS_BYTES = 156 * 1024;
constexpr size_t WS_WIN = 0;
constexpr size_t WS_WOUT = WS_WIN + (size_t)NPAD * DM * 2;
constexpr size_t WS_WG = WS_WOUT + (size_t)DM * DM * 2;
constexpr size_t WS_WP = WS_WG + (size_t)DM * DM * 2;
constexpr size_t WS_STATS = WS_WP + (size_t)DM * DPLE * 2;
constexpr size_t WS_DEC = WS_STATS + (size_t)T_TOK * 8;
constexpr size_t WS_HBF = WS_DEC + (size_t)32 * 64 * 64 * 4;
constexpr size_t WS_PBF = WS_HBF + (size_t)T_TOK * DM * 2;
constexpr size_t WS_PROJ = WS_PBF + (size_t)T_TOK * DPLE * 2;
constexpr size_t WS_R32 = WS_PROJ + (size_t)T_TOK * DM * 2;
constexpr size_t WS_MIX = WS_PROJ + (size_t)T_TOK * NPROJ * 2;
constexpr size_t WS_KV = WS_MIX + (size_t)T_TOK * DM * 2;
constexpr size_t WS_SPREV = WS_KV + (size_t)32 * 64 * 128 * 64 * 4;
constexpr size_t WS_EG = WS_SPREV + (size_t)32 * 64 * 128 * 64 * 2;
constexpr size_t WS_BAR = WS_EG + (size_t)2048 * 4096 * 2;
constexpr size_t WS_END = WS_BAR + 16384;

struct Params {
    const float* x; const float* p; const float* ln_in_g; const float* ln_in_b; const float* w_in; const float* w_gla_gate; const float* b_gla_gate;
    const float* rel_bias; const float* gla_norm_g; const float* w_out; const float* w_ple; const float* w_ple_gate; const float* b_ple_gate;
    const float* ln_g; const float* ln_b; float* out; unsigned char* ws;
};

typedef __bf16 bf16x2_hw __attribute__((ext_vector_type(2)));
typedef float f32x2_hw __attribute__((ext_vector_type(2)));
typedef short s16x4 __attribute__((ext_vector_type(4)));
__device__ __forceinline__ unsigned pk2(float lo, float hi) { f32x2_hw v = {lo, hi}; bf16x2_hw b = __builtin_convertvector(v, bf16x2_hw); return __builtin_bit_cast(unsigned, b); }
__device__ __forceinline__ unsigned f2bf(float f) { return pk2(f, 0.f) & 0xffffu; }
__device__ __forceinline__ s16x4 tr_read(PG8_LAS const unsigned char* p) { return __builtin_amdgcn_ds_read_tr16_b64_v4i16((PG8_LAS s16x4*)p); }
__device__ __forceinline__ float bflo(unsigned u) { return __builtin_bit_cast(float, u << 16); }
__device__ __forceinline__ float bfhi(unsigned u) { return __builtin_bit_cast(float, u & 0xffff0000u); }
__device__ __forceinline__ float bf2f(bf16_t v) { return __builtin_bit_cast(float, (unsigned)v << 16); }
__device__ __forceinline__ float wave_sum(float v) {
#pragma unroll
    for (int o = 1; o < 64; o <<= 1) v += __shfl_xor(v, o);
    return v;
}
__device__ __forceinline__ int opaque_tid() { int t = threadIdx.x; asm volatile("" : "+v"(t)); return t; }
__device__ __forceinline__ void lds_barrier() { asm volatile("s_waitcnt lgkmcnt(0)" ::: "memory"); __builtin_amdgcn_s_barrier(); asm volatile("" ::: "memory"); }
__device__ __forceinline__ float max_rows4(float v) {
    float a = v, b = v;
    asm("s_nop 1\n\tv_permlane16_swap_b32 %0, %1" : "+v"(a), "+v"(b));
    a = fmaxf(a, b); b = a;
    asm("s_nop 1\n\tv_permlane32_swap_b32 %0, %1" : "+v"(a), "+v"(b));
    return fmaxf(a, b);
}
__device__ __forceinline__ float sum_rows4(float v) {
    float a = v, b = v;
    asm("s_nop 1\n\tv_permlane16_swap_b32 %0, %1" : "+v"(a), "+v"(b));
    a = a + b; b = a;
    asm("s_nop 1\n\tv_permlane32_swap_b32 %0, %1" : "+v"(a), "+v"(b));
    return a + b;
}
__device__ __forceinline__ float sigmoidf_(float z) { return __builtin_amdgcn_rcpf(1.f + __expf(-z)); }
__device__ __forceinline__ float siluf_(float z) { return z * __builtin_amdgcn_rcpf(1.f + __expf(-z)); }
__device__ __forceinline__ f32x4 mfma16(bf16x8 a, bf16x8 b, f32x4 c) { return __builtin_amdgcn_mfma_f32_16x16x32_bf16(a, b, c, 0, 0, 0); }

__device__ __forceinline__ void transpose_item(const float* W, int K, int N, int nblk, bf16_t* WT, float* scr, int item, int lane) {
    const int kb = item / nblk, nb = item - kb * nblk, k0 = 64 * kb, n0 = 32 * nb;
    const int nn = n0 + (lane & 31);
#pragma unroll 8
    for (int i = 0; i < 32; ++i) { const int kk = 2 * i + (lane >> 5); scr[kk * 33 + (lane & 31)] = (nn < N) ? W[(size_t)(k0 + kk) * N + nn] : 0.f; }
    asm volatile("s_waitcnt lgkmcnt(0)" ::: "memory");
    const int c = lane & 7;
#pragma unroll
    for (int j = 0; j < 4; ++j) { const int n = (lane >> 3) + 8 * j; const float* s = scr + (8 * c) * 33 + n;
        u32x4 o; o.x = pk2(s[0 * 33], s[1 * 33]); o.y = pk2(s[2 * 33], s[3 * 33]); o.z = pk2(s[4 * 33], s[5 * 33]); o.w = pk2(s[6 * 33], s[7 * 33]);
        *(u32x4*)(WT + (size_t)(n0 + n) * K + k0 + 8 * c) = o; }
    asm volatile("s_waitcnt lgkmcnt(0)" ::: "memory");
}

__device__ __forceinline__ void prep_phase(const Params& P, unsigned char* lds) {
    const int tid = threadIdx.x, wave = tid >> 6, lane = tid & 63;
    unsigned char* ws = P.ws;
    float* scr = (float*)(lds + wave * 16384);
    const int gw = blockIdx.x * NWAVES + wave, NGW = gridDim.x * NWAVES;
    constexpr int I_IN = (DM / 64) * (NPAD / 32), I_OUT = (DM / 64) * (DM / 32), I_P = (DPLE / 64) * (DM / 32);
    constexpr int NITEMS = I_IN + 2 * I_OUT + I_P;
    for (int it = gw; it < NITEMS; it += NGW) {
        int r = it;
        if (r < I_IN) { transpose_item(P.w_in, DM, NPROJ, NPAD / 32, (bf16_t*)(ws + WS_WIN), scr, r, lane); continue; } r -= I_IN;
        if (r < I_OUT) { transpose_item(P.w_out, DM, DM, DM / 32, (bf16_t*)(ws + WS_WOUT), scr, r, lane); continue; } r -= I_OUT;
        if (r < I_OUT) { transpose_item(P.w_ple_gate, DM, DM, DM / 32, (bf16_t*)(ws + WS_WG), scr, r, lane); continue; } r -= I_OUT;
        transpose_item(P.w_ple, DPLE, DM, DM / 32, (bf16_t*)(ws + WS_WP), scr, r, lane);
    }
    bf16_t* hbf = (bf16_t*)(ws + WS_HBF); float2* stats = (float2*)(ws + WS_STATS);
    f32x4 gg[4], bb[4];
#pragma unroll
    for (int j = 0; j < 4; ++j) { gg[j] = ((const f32x4*)P.ln_in_g)[lane + 64 * j]; bb[j] = ((const f32x4*)P.ln_in_b)[lane + 64 * j]; }
    for (int m = gw; m < T_TOK; m += NGW) {
        const f32x4* xr = (const f32x4*)(P.x + (size_t)m * DM) + lane;
        f32x4 v[4]; float s = 0.f;
#pragma unroll
        for (int j = 0; j < 4; ++j) { v[j] = __builtin_nontemporal_load(&xr[64 * j]); s += (v[j].x + v[j].y) + (v[j].z + v[j].w); }
        const float mean = wave_sum(s) * (1.f / DM); float s2 = 0.f;
#pragma unroll
        for (int j = 0; j < 4; ++j) { v[j] = v[j] - mean; s2 += (v[j].x * v[j].x + v[j].y * v[j].y) + (v[j].z * v[j].z + v[j].w * v[j].w); }
        const float rstd = __builtin_amdgcn_rsqf(wave_sum(s2) * (1.f / DM) + 1e-5f);
        u32x2* o8 = (u32x2*)(hbf + (size_t)m * DM) + lane;
#pragma unroll
        for (int j = 0; j < 4; ++j) { const f32x4 y = v[j] * rstd * gg[j] + bb[j]; u32x2 o; o.x = pk2(y.x, y.y); o.y = pk2(y.z, y.w); o8[64 * j] = o; }
        if (lane == 0) stats[m] = make_float2(mean, rstd);
    }
    bf16_t* pbf = (bf16_t*)(ws + WS_PBF);
    for (size_t i = (size_t)blockIdx.x * NTHR + tid; i < (size_t)T_TOK * DPLE / 8; i += (size_t)gridDim.x * NTHR) {
        const f32x4 a = __builtin_nontemporal_load(&((const f32x4*)P.p)[2 * i]), b = __builtin_nontemporal_load(&((const f32x4*)P.p)[2 * i + 1]);
        u32x4 o; o.x = pk2(a.x, a.y); o.y = pk2(a.z, a.w); o.z = pk2(b.x, b.y); o.w = pk2(b.z, b.w);
        ((u32x4*)pbf)[i] = o;
    }
}

struct EpiBf16 {
    static constexpr bool PERM = true, AFTER_DRAIN = false;
    bf16_t* O; int ldc; int ncols;
    __device__ __forceinline__ void operator()(const f32x4 (&acc)[2][2][4][2], const pg8::Unit& u, int wr, int wc, int fr, int fq) const {
        const int row0 = u.pm * 256 + wr * 64 + fr, col0 = u.pn * 256 + wc * 32 + 8 * fq;
#pragma unroll
        for (int ai = 0; ai < 2; ++ai)
#pragma unroll
            for (int m = 0; m < 4; ++m) { bf16_t* rowp = O + (size_t)(row0 + ai * 128 + m * 16) * ldc;
#pragma unroll
                for (int bj = 0; bj < 2; ++bj) { const int c = col0 + bj * 128;
                    if (c < ncols) { const f32x4 v0 = acc[ai][bj][m][0], v1 = acc[ai][bj][m][1];
                        u32x4 o; o.x = pk2(v0[0], v0[1]); o.y = pk2(v0[2], v0[3]); o.z = pk2(v1[0], v1[1]); o.w = pk2(v1[2], v1[3]);
                        *(u32x4*)(rowp + c) = o; } } }
    }
};
struct EpiRes {
    static constexpr bool PERM = true, AFTER_DRAIN = false;
    const bf16_t* hbf; bf16_t* rbf;
    __device__ __forceinline__ void operator()(const f32x4 (&acc)[2][2][4][2], const pg8::Unit& u, int wr, int wc, int fr, int fq) const {
        const int row0 = u.pm * 256 + wr * 64 + fr, col0 = u.pn * 256 + wc * 32 + 8 * fq;
#pragma unroll
        for (int bj = 0; bj < 2; ++bj) { const int c = col0 + bj * 128;
#pragma unroll
            for (int ai = 0; ai < 2; ++ai)
#pragma unroll
                for (int m = 0; m < 4; ++m) { const size_t row = (size_t)(row0 + ai * 128 + m * 16);
                    const u32x4 hh = *(const u32x4*)(hbf + row * DM + c);
                    const f32x4 a0 = acc[ai][bj][m][0], a1 = acc[ai][bj][m][1];
                    u32x4 o; o.x = pk2(bflo(hh.x) * ALPHA + a0[0], bfhi(hh.x) * ALPHA + a0[1]); o.y = pk2(bflo(hh.y) * ALPHA + a0[2], bfhi(hh.y) * ALPHA + a0[3]);
                    o.z = pk2(bflo(hh.z) * ALPHA + a1[0], bfhi(hh.z) * ALPHA + a1[1]); o.w = pk2(bflo(hh.w) * ALPHA + a1[2], bfhi(hh.w) * ALPHA + a1[3]);
                    *(u32x4*)(rbf + row * DM + c) = o; } }
    }
};
struct EpiGate {
    static constexpr bool PERM = true, AFTER_DRAIN = false;
    const float* bias; const bf16_t* ple; const bf16_t* rbf; bf16_t* ybf;
    __device__ __forceinline__ void operator()(const f32x4 (&acc)[2][2][4][2], const pg8::Unit& u, int wr, int wc, int fr, int fq) const {
        const int row0 = u.pm * 256 + wr * 64 + fr, col0 = u.pn * 256 + wc * 32 + 8 * fq;
#pragma unroll
        for (int bj = 0; bj < 2; ++bj) { const int c = col0 + bj * 128;
            const f32x4 b0 = *(const f32x4*)(bias + c), b1 = *(const f32x4*)(bias + c + 4);
#pragma unroll
            for (int ai = 0; ai < 2; ++ai)
#pragma unroll
                for (int m = 0; m < 4; ++m) { const size_t row = (size_t)(row0 + ai * 128 + m * 16);
                    const u32x4 rr = *(const u32x4*)(rbf + row * DM + c);
                    const u32x4 pl = *(const u32x4*)(ple + row * DM + c);
                    const f32x4 z0 = acc[ai][bj][m][0] + b0, z1 = acc[ai][bj][m][1] + b1;
                    const float y0 = bflo(rr.x) + sigmoidf_(z0[0]) * bflo(pl.x), y1 = bfhi(rr.x) + sigmoidf_(z0[1]) * bfhi(pl.x);
                    const float y2 = bflo(rr.y) + sigmoidf_(z0[2]) * bflo(pl.y), y3 = bfhi(rr.y) + sigmoidf_(z0[3]) * bfhi(pl.y);
                    const float y4 = bflo(rr.z) + sigmoidf_(z1[0]) * bflo(pl.z), y5 = bfhi(rr.z) + sigmoidf_(z1[1]) * bfhi(pl.z);
                    const float y6 = bflo(rr.w) + sigmoidf_(z1[2]) * bflo(pl.w), y7 = bfhi(rr.w) + sigmoidf_(z1[3]) * bfhi(pl.w);
                    u32x4 o; o.x = pk2(y0, y1); o.y = pk2(y2, y3); o.z = pk2(y4, y5); o.w = pk2(y6, y7);
                    *(u32x4*)(ybf + row * DM + c) = o; } }
    }
};

constexpr int KR_OFF = 0, VR_OFF = 9 * 64 * 128, XB_OFF = 2 * VR_OFF, REL_OFF = XB_OFF + 10 * 256 * 4;
constexpr float LOG2E = 1.4426950408889634f;
template <int NT, bool LKA, bool LKB>
__device__ __forceinline__ void attn_tiles(int slotA, int slotB, const bf16x8 q0, const bf16x8 q1, float bconst, const unsigned (&bzA)[8], const unsigned (&bzB)[8],
                                           PG8_LAS const unsigned char* kr, const unsigned (&koff)[2], PG8_LAS const unsigned char* vr, const unsigned (&voff)[4],
                                           float& m_run, float& sum, f32x4 (&o)[4]) {
    f32x4 st[NT * 4];
#pragma unroll
    for (int n = 0; n < NT; ++n) {
        PG8_LAS const unsigned char* kb_ = kr + (n == 0 ? slotA : slotB) * 8192;
#pragma unroll
        for (int ti = 0; ti < 4; ++ti) {
            const bf16x8 k0 = *(PG8_LAS const bf16x8*)(kb_ + ti * 2048 + koff[0]), k1 = *(PG8_LAS const bf16x8*)(kb_ + ti * 2048 + koff[1]);
            f32x4 z = {0.f, 0.f, 0.f, 0.f}; z = mfma16(k0, q0, z); z = mfma16(k1, q1, z); st[n * 4 + ti] = z;
        }
    }
    float mx = m_run;
#pragma unroll
    for (int n = 0; n < NT; ++n)
#pragma unroll
        for (int ti = 0; ti < 4; ++ti)
#pragma unroll
            for (int j = 0; j < 4; ++j) {
                float bias = bconst;
                if (n == 0 ? LKA : LKB) { const unsigned w = (n == 0 ? bzA : bzB)[ti * 2 + (j >> 1)]; bias = (j & 1) ? bfhi(w) : bflo(w); }
                const float sv = st[n * 4 + ti][j] * (0.125f * LOG2E) + bias;
                st[n * 4 + ti][j] = sv; mx = fmaxf(mx, sv);
            }
    mx = max_rows4(mx);
    const float sc = __builtin_amdgcn_exp2f(m_run - mx); m_run = mx;
    float ps = 0.f;
#pragma unroll
    for (int i = 0; i < NT * 4; ++i)
#pragma unroll
        for (int j = 0; j < 4; ++j) { const float pe = __builtin_amdgcn_exp2f(st[i][j] - mx); ps += pe; st[i][j] = pe; }
    sum = sum * sc + ps;
#pragma unroll
    for (int db = 0; db < 4; ++db) o[db] = o[db] * sc;
#pragma unroll
    for (int n = 0; n < NT; ++n) {
        PG8_LAS const unsigned char* sb = vr + (n == 0 ? slotA : slotB) * 8192;
#pragma unroll
        for (int kb = 0; kb < 2; ++kb) {
            const int t0 = n * 4 + 2 * kb;
            u32x4 pw; pw.x = pk2(st[t0][0], st[t0][1]); pw.y = pk2(st[t0][2], st[t0][3]); pw.z = pk2(st[t0 + 1][0], st[t0 + 1][1]); pw.w = pk2(st[t0 + 1][2], st[t0 + 1][3]);
            const bf16x8 pf = __builtin_bit_cast(bf16x8, pw);
#pragma unroll
            for (int db = 0; db < 4; ++db) {
                const s16x4 a0 = tr_read(sb + kb * 4096 + voff[db]), a1 = tr_read(sb + kb * 4096 + 2048 + voff[db]);
                o[db] = mfma16(__builtin_shufflevector(a0, a1, 0, 1, 2, 3, 4, 5, 6, 7), pf, o[db]);
            }
        }
    }
}
__device__ __forceinline__ void attn_unit(const bf16_t* __restrict__ proj, const float* __restrict__ rel_bias, bf16_t* __restrict__ mix, unsigned char* lds, int b, int h, int c_begin, int nsteps) {
    const int tid = opaque_tid(), wave = tid >> 6, lane = tid & 63, l15 = lane & 15, g = lane >> 4;
    PG8_LAS unsigned char* kr = (PG8_LAS unsigned char*)lds + KR_OFF;
    PG8_LAS unsigned char* vr = (PG8_LAS unsigned char*)lds + VR_OFF;
    float* xb = (float*)(lds + XB_OFF);
    float* rl = (float*)(lds + REL_OFF);
    const size_t brow = (size_t)b * SEQ;
    const int qg = wave & 3, kh = wave >> 2, qi = qg * 16 + l15;
    for (int i = tid; i < 257; i += NTHR) rl[i] = rel_bias[h * 257 + i] * LOG2E;
    const int skey = tid >> 3, sch = tid & 7;
    const unsigned kdst = (unsigned)(skey * 128 + ((sch ^ (skey & 7)) * 16));
    const unsigned vdst = (unsigned)(skey * 128 + ((sch ^ (((skey >> 1) & 3) << 1)) * 16));
    const bf16_t* ksrc = proj + (brow + skey) * NPROJ + C_AK + h * 64 + sch * 8;
    const bf16_t* vsrc = proj + (brow + skey) * NPROJ + C_AV + h * 64 + sch * 8;
#pragma unroll
    for (int k = 0; k < 8; ++k) {
        const int ac = c_begin - 8 + k;
        u32x4 kk = {0u, 0u, 0u, 0u}, vv = {0u, 0u, 0u, 0u};
        if (ac >= 0) { kk = *(const u32x4*)(ksrc + (size_t)ac * 64 * NPROJ); vv = *(const u32x4*)(vsrc + (size_t)ac * 64 * NPROJ); }
        const int slot = (ac + 9) % 9;
        *(PG8_LAS u32x4*)(kr + slot * 8192 + kdst) = kk; *(PG8_LAS u32x4*)(vr + slot * 8192 + vdst) = vv;
    }
    unsigned koff[2], voff[4];
#pragma unroll
    for (int ks = 0; ks < 2; ++ks) koff[ks] = (unsigned)(l15 * 128 + (((ks * 4 + g) ^ (l15 & 7)) * 16));
    { const int q = l15 >> 2, p = l15 & 3, sw = ((2 * g + (q >> 1)) & 3) << 1;
#pragma unroll
      for (int db = 0; db < 4; ++db) voff[db] = (unsigned)((4 * g + q) * 128 + (((2 * db + (p >> 1)) ^ sw) * 16) + (p & 1) * 8); }
    lds_barrier();
    unsigned bz[3][8];
#pragma unroll
    for (int bl = 0; bl < 3; ++bl)
#pragma unroll
        for (int ti = 0; ti < 4; ++ti)
#pragma unroll
            for (int jp = 0; jp < 2; ++jp) { int r0 = qi + 512 - ((6 + bl) * 64 + ti * 16 + 4 * g + 2 * jp); int r1 = r0 - 1; r0 = r0 > 128 ? 128 : r0; r1 = r1 > 128 ? 128 : r1; bz[bl][ti * 2 + jp] = pk2(rl[r0 + 128], rl[r1 + 128]); }
    const float bconst = rl[256];
    u32x4 pk = *(const u32x4*)(ksrc + (size_t)c_begin * 64 * NPROJ), pv = *(const u32x4*)(vsrc + (size_t)c_begin * 64 * NPROJ);
    size_t qrow = brow + (size_t)c_begin * 64 + qi;
    bf16x8 qf0 = *(const bf16x8*)(proj + qrow * NPROJ + C_AQ + h * 64 + g * 8), qf1 = *(const bf16x8*)(proj + qrow * NPROJ + C_AQ + h * 64 + 32 + g * 8);
    u32x2 gt[4];
#pragma unroll
    for (int db = 0; db < 4; ++db) gt[db] = *(const u32x2*)(proj + qrow * NPROJ + C_AG + h * 64 + db * 16 + 4 * g);
    const int c_end = c_begin + nsteps;
#pragma unroll 1
    for (int c = c_begin; c < c_end; ++c) {
        lds_barrier();
        { const int slot = c % 9; *(PG8_LAS u32x4*)(kr + slot * 8192 + kdst) = pk; *(PG8_LAS u32x4*)(vr + slot * 8192 + vdst) = pv; }
        const bf16x8 cq0 = qf0, cq1 = qf1; u32x2 cg[4];
#pragma unroll
        for (int db = 0; db < 4; ++db) cg[db] = gt[db];
        const size_t crow = qrow;
        if (c + 1 < c_end) {
            pk = *(const u32x4*)(ksrc + (size_t)(c + 1) * 64 * NPROJ); pv = *(const u32x4*)(vsrc + (size_t)(c + 1) * 64 * NPROJ);
            qrow += 64;
            qf0 = *(const bf16x8*)(proj + qrow * NPROJ + C_AQ + h * 64 + g * 8); qf1 = *(const bf16x8*)(proj + qrow * NPROJ + C_AQ + h * 64 + 32 + g * 8);
#pragma unroll
            for (int db = 0; db < 4; ++db) gt[db] = *(const u32x2*)(proj + qrow * NPROJ + C_AG + h * 64 + db * 16 + 4 * g);
        }
        lds_barrier();
        float m_run = -3.0e38f, sum = 0.f;
        f32x4 o[4];
#pragma unroll
        for (int db = 0; db < 4; ++db) o[db] = (f32x4){0.f, 0.f, 0.f, 0.f};
        const int nskip = 8 - c;
#define ATT1(LK, sl, bzz) attn_tiles<1, LK, false>((sl), 0, cq0, cq1, bconst, bzz, bzz, kr, koff, vr, voff, m_run, sum, o)
#define ATT2(LA, LB, sa, sb_, bza, bzb) attn_tiles<2, LA, LB>((sa), (sb_), cq0, cq1, bconst, bza, bzb, kr, koff, vr, voff, m_run, sum, o)
        if (kh == 0) {
            if (nskip <= 0) { ATT2(false, false, (c + 1) % 9, (c + 2) % 9, bz[0], bz[0]); ATT2(false, false, (c + 3) % 9, (c + 4) % 9, bz[0], bz[0]); ATT1(false, (c + 5) % 9, bz[0]); }
            else {
#pragma unroll 1
                for (int bc = 0; bc < 5; ++bc) if (bc >= nskip) ATT1(false, (c + 1 + bc) % 9, bz[0]);
            }
        } else {
            if (nskip <= 5) { ATT2(false, true, (c + 6) % 9, (c + 7) % 9, bz[0], bz[0]); ATT2(true, true, (c + 8) % 9, c % 9, bz[1], bz[2]); }
            else {
                if (6 >= nskip) ATT1(true, (c + 7) % 9, bz[0]);
                if (7 >= nskip) ATT1(true, (c + 8) % 9, bz[1]);
                ATT1(true, c % 9, bz[2]);
            }
            float* x = xb + qg * 64 + lane;
            x[0] = m_run; x[256] = sum;
#pragma unroll
            for (int db = 0; db < 4; ++db) { x[(2 + 2 * db) * 256] = __builtin_bit_cast(float, pk2(o[db][0], o[db][1])); x[(3 + 2 * db) * 256] = __builtin_bit_cast(float, pk2(o[db][2], o[db][3])); }
        }
        lds_barrier();
        if (kh == 0) {
            const float* x = xb + qg * 64 + lane;
            const float m1 = x[0], s1 = x[256];
            const float m = fmaxf(m_run, m1);
            const float a0 = __builtin_amdgcn_exp2f(m_run - m), a1 = __builtin_amdgcn_exp2f(m1 - m);
            float tot = sum * a0 + s1 * a1;
            tot = sum_rows4(tot);
            const float inv = __builtin_amdgcn_rcpf(tot);
#pragma unroll
            for (int db = 0; db < 4; ++db) {
                const unsigned w0 = __builtin_bit_cast(unsigned, x[(2 + 2 * db) * 256]), w1 = __builtin_bit_cast(unsigned, x[(3 + 2 * db) * 256]);
                const int d0 = db * 16 + 4 * g;
                const float v0 = (o[db][0] * a0 + bflo(w0) * a1) * inv * siluf_(bflo(cg[db].x)), v1 = (o[db][1] * a0 + bfhi(w0) * a1) * inv * siluf_(bfhi(cg[db].x));
                const float v2 = (o[db][2] * a0 + bflo(w1) * a1) * inv * siluf_(bflo(cg[db].y)), v3 = (o[db][3] * a0 + bfhi(w1) * a1) * inv * siluf_(bfhi(cg[db].y));
                u32x2 ov; ov.x = pk2(v0, v1); ov.y = pk2(v2, v3);
                *(u32x2*)(mix + crow * DM + h * 64 + d0) = ov;
            }
        }
    }
    lds_barrier();
}

constexpr int GS = 72;
constexpr int G2_GLR = 0, G2_SEG = 2048, G2_K = 3072, G2_Q = 11264, G2_V = 19456, G2_T = 35840, G2_BYTES = G2_T + 4 * 64 * GS * 2;
__device__ __forceinline__ void gla_gates(const unsigned char* base, const float (&w)[16], float bb, int tq, int d, float (&L)[16], float& Lend) {
    float* segtot = (float*)(base + G2_SEG);
    float run = 0.f;
#pragma unroll
    for (int i = 0; i < 16; ++i) {
        const unsigned char* gp = base + G2_GLR + (tq * 16 + i) * 32;
        const u32x4 a = *(const u32x4*)gp, b2 = *(const u32x4*)(gp + 16);
        float z = bb;
        z += bflo(a.x) * w[0] + bfhi(a.x) * w[1] + bflo(a.y) * w[2] + bfhi(a.y) * w[3] + bflo(a.z) * w[4] + bfhi(a.z) * w[5] + bflo(a.w) * w[6] + bfhi(a.w) * w[7];
        z += bflo(b2.x) * w[8] + bfhi(b2.x) * w[9] + bflo(b2.y) * w[10] + bfhi(b2.y) * w[11] + bflo(b2.z) * w[12] + bfhi(b2.z) * w[13] + bflo(b2.w) * w[14] + bfhi(b2.w) * w[15];
        const float ls = fminf(z, 0.f) - __logf(1.f + __expf(-fabsf(z)));
        run += ls * (1.f / 16.f); L[i] = run;
    }
    segtot[tq * 64 + d] = run;
    lds_barrier();
    float off = 0.f, tot = 0.f;
#pragma unroll
    for (int q = 0; q < 4; ++q) { const float v = segtot[q * 64 + d]; tot += v; if (q < tq) off += v; }
#pragma unroll
    for (int i = 0; i < 16; ++i) L[i] += off;
    Lend = tot;
}
#define GLA_ROW0(item) ((size_t)((item) >> 8) * SEQ + (size_t)(((item) >> 2) & 63) * 64)
__device__ __forceinline__ void gla_kv_phase(const Params& P, const bf16_t* __restrict__ proj, bf16_t* __restrict__ KV, float* __restrict__ DEC, bf16_t* __restrict__ EG, unsigned char* lds) {
    const int tid = opaque_tid(), wave = tid >> 6, lane = tid & 63, l15 = lane & 15, g = lane >> 4, grp = wave >> 2, w4 = wave & 3, tg = tid & 255;
    unsigned char* base = lds + grp * G2_BYTES;
    PG8_LAS const unsigned char* vl = (PG8_LAS const unsigned char*)base + G2_V;
    bf16_t* kendT = (bf16_t*)(base + G2_T);
    const int step = 2 * (int)gridDim.x;
    int item = blockIdx.x * 2 + grp;
    const int h = item & 3;
    float w[16];
#pragma unroll
    for (int r = 0; r < 16; ++r) w[r] = P.w_gla_gate[r * 256 + h * 64 + lane];
    const float bb = P.b_gla_gate[h * 64 + lane];
    const int kt_ = tg >> 3, kch = tg & 7, vs_ = tg >> 4, vch = tg & 15;
    unsigned voff[8];
    { const int q = l15 >> 2, p = l15 & 3, sw = (4 * (g & 1) + q) << 1;
#pragma unroll
      for (int vb = 0; vb < 8; ++vb) voff[vb] = (unsigned)((4 * g + q) * 256 + (((2 * vb + (p >> 1)) ^ sw) * 16) + (p & 1) * 8); }
    u32x4 pg = {0u, 0u, 0u, 0u}, pk[2], pv[4];
#define GLA_PF_KV(it_) do { const bf16_t* r0_ = proj + GLA_ROW0(it_) * NPROJ; \
        if (tg < 128) pg = *(const u32x4*)(r0_ + (size_t)(tg >> 1) * NPROJ + C_LR + (tg & 1) * 8); \
        _Pragma("unroll") for (int i_ = 0; i_ < 2; ++i_) pk[i_] = *(const u32x4*)(r0_ + (size_t)(kt_ + 32 * i_) * NPROJ + C_GK + h * 64 + kch * 8); \
        _Pragma("unroll") for (int i_ = 0; i_ < 4; ++i_) pv[i_] = *(const u32x4*)(r0_ + (size_t)(vs_ + 16 * i_) * NPROJ + C_GV + h * 128 + vch * 8); } while (0)
    GLA_PF_KV(item);
    for (; item < 2048; item += step) {
        lds_barrier();
        if (tg < 128) *(u32x4*)(base + G2_GLR + tg * 16) = pg;
#pragma unroll
        for (int i = 0; i < 2; ++i) *(u32x4*)(base + G2_K + (kt_ + 32 * i) * 128 + kch * 16) = pk[i];
#pragma unroll
        for (int i = 0; i < 4; ++i) { const int sr = vs_ + 16 * i; *(u32x4*)(base + G2_V + sr * 256 + ((vch ^ ((sr & 7) << 1)) * 16)) = pv[i]; }
        const int cur = item;
        if (item + step < 2048) GLA_PF_KV(item + step);
        lds_barrier();
        float L[16], Lend;
        gla_gates(base, w, bb, w4, lane, L, Lend);
#pragma unroll
        for (int i = 0; i < 16; ++i) { const int t = w4 * 16 + i;
            const float kv = bf2f(*(const bf16_t*)(base + G2_K + t * 128 + lane * 2));
            kendT[lane * GS + t] = (bf16_t)f2bf(kv * __expf(Lend - L[i]));
            EG[(size_t)cur * 4096 + t * 64 + lane] = (bf16_t)f2bf(__expf(L[i])); }
        const size_t sidx = (size_t)((cur >> 8) * 4 + h) * 64 + ((cur >> 2) & 63);
        if (w4 == 0) DEC[sidx * 64 + lane] = __expf(Lend);
        lds_barrier();
        bf16_t* kvo = KV + sidx * 8192;
#pragma unroll
        for (int vi = 0; vi < 2; ++vi) { const int vb = 2 * w4 + vi;
            bf16x8 af[2];
#pragma unroll
            for (int kb = 0; kb < 2; ++kb) { const s16x4 a0 = tr_read(vl + kb * 8192 + voff[vb]), a1 = tr_read(vl + kb * 8192 + 4096 + voff[vb]); af[kb] = __builtin_shufflevector(a0, a1, 0, 1, 2, 3, 4, 5, 6, 7); }
#pragma unroll
            for (int db = 0; db < 4; ++db) {
                f32x4 acc = {0.f, 0.f, 0.f, 0.f};
#pragma unroll
                for (int kb = 0; kb < 2; ++kb) {
                    const bf16_t* bp = kendT + (db * 16 + l15) * GS + kb * 32 + 4 * g;
                    const u32x2 b0 = *(const u32x2*)bp, b1 = *(const u32x2*)(bp + 16);
                    u32x4 bw; bw.x = b0.x; bw.y = b0.y; bw.z = b1.x; bw.w = b1.y;
                    acc = mfma16(__builtin_bit_cast(bf16x8, bw), af[kb], acc);
                }
                u32x2 ov; ov.x = pk2(acc[0], acc[1]); ov.y = pk2(acc[2], acc[3]);
                *(u32x2*)(kvo + (vb * 16 + l15) * 64 + db * 16 + 4 * g) = ov;
            } }
    }
    lds_barrier();
#undef GLA_PF_KV
}
constexpr int G3_V = 0, G3_T = 16384, G3_BYTES = G3_T + 4 * 64 * GS * 2;
__device__ __forceinline__ void gla_out_phase(const Params& P, const bf16_t* __restrict__ proj, const bf16_t* __restrict__ SP, const bf16_t* __restrict__ EG, bf16_t* __restrict__ mix, unsigned char* lds) {
    const int tid = opaque_tid(), wave = tid >> 6, lane = tid & 63, l15 = lane & 15, g = lane >> 4, grp = wave >> 2, w4 = wave & 3, tg = tid & 255;
    unsigned char* base = lds + grp * G3_BYTES;
    PG8_LAS const unsigned char* vl = (PG8_LAS const unsigned char*)base + G3_V;
    bf16_t* qfw = (bf16_t*)(base + G3_T); bf16_t* qbw = qfw + 64 * GS; bf16_t* kng = qbw + 64 * GS; bf16_t* kps = kng + 64 * GS;
    const int step = 2 * (int)gridDim.x;
    int item = blockIdx.x * 2 + grp;
    const int h = item & 3;
    const int kt_ = tg >> 3, kch = tg & 7, vs_ = tg >> 4, vch = tg & 15;
    unsigned voff[8];
    { const int q = l15 >> 2, p = l15 & 3, sw = (4 * (g & 1) + q) << 1;
#pragma unroll
      for (int vb = 0; vb < 8; ++vb) voff[vb] = (unsigned)((4 * g + q) * 256 + (((2 * vb + (p >> 1)) ^ sw) * 16) + (p & 1) * 8); }
    const int tb = w4, tl = tb * 16 + l15;
    u32x4 pk[2], pq[2], pe[2], pv[4];
#define GLA_PF_OUT(it_) do { const bf16_t* r0_ = proj + GLA_ROW0(it_) * NPROJ; const bf16_t* e0_ = EG + (size_t)(it_) * 4096; \
        _Pragma("unroll") for (int i_ = 0; i_ < 2; ++i_) { pk[i_] = *(const u32x4*)(r0_ + (size_t)(kt_ + 32 * i_) * NPROJ + C_GK + h * 64 + kch * 8); \
                                                          pq[i_] = *(const u32x4*)(r0_ + (size_t)(kt_ + 32 * i_) * NPROJ + C_GQ + h * 64 + kch * 8); \
                                                          pe[i_] = *(const u32x4*)(e0_ + (kt_ + 32 * i_) * 64 + kch * 8); } \
        _Pragma("unroll") for (int i_ = 0; i_ < 4; ++i_) pv[i_] = *(const u32x4*)(r0_ + (size_t)(vs_ + 16 * i_) * NPROJ + C_GV + h * 128 + vch * 8); } while (0)
    GLA_PF_OUT(item);
    for (; item < 2048; item += step) {
        lds_barrier();
#pragma unroll
        for (int i = 0; i < 2; ++i) {
            u32x4 wf, wb, wn, wp;
#pragma unroll
            for (int c2 = 0; c2 < 4; ++c2) {
                const unsigned qq = pq[i][c2], kk = pk[i][c2], ee = pe[i][c2];
                const float e0 = bflo(ee), e1 = bfhi(ee), r0 = __builtin_amdgcn_rcpf(e0), r1 = __builtin_amdgcn_rcpf(e1);
                const float q0 = bflo(qq) * 0.125f, q1 = bfhi(qq) * 0.125f, k0 = bflo(kk), k1 = bfhi(kk);
                wf[c2] = pk2(q0 * e0, q1 * e1); wb[c2] = pk2(q0 * r0, q1 * r1); wn[c2] = pk2(k0 * r0, k1 * r1); wp[c2] = pk2(k0 * e0, k1 * e1);
            }
            const int off = (kt_ + 32 * i) * GS + kch * 8;
            *(u32x4*)(qfw + off) = wf; *(u32x4*)(qbw + off) = wb; *(u32x4*)(kng + off) = wn; *(u32x4*)(kps + off) = wp;
        }
#pragma unroll
        for (int i = 0; i < 4; ++i) { const int sr = vs_ + 16 * i; *(u32x4*)(base + G3_V + sr * 256 + ((vch ^ ((sr & 7) << 1)) * 16)) = pv[i]; }
        const int cur = item;
        if (item + step < 2048) GLA_PF_OUT(item + step);
        const size_t row0 = GLA_ROW0(cur);
        const size_t trow = row0 + tl;
        const bf16_t* sp = SP + ((size_t)((cur >> 8) * 4 + h) * 64 + ((cur >> 2) & 63)) * 8192;
        u32x2 gt[8]; f32x4 gnv[8];
#pragma unroll
        for (int vb = 0; vb < 8; ++vb) { gt[vb] = *(const u32x2*)(proj + trow * NPROJ + C_GG + h * 128 + vb * 16 + 4 * g); gnv[vb] = *(const f32x4*)(P.gla_norm_g + h * 128 + vb * 16 + 4 * g); }
        lds_barrier();
        bf16x8 sf[8][2];
#pragma unroll
        for (int vb = 0; vb < 8; ++vb)
#pragma unroll
            for (int ks = 0; ks < 2; ++ks) sf[vb][ks] = *(const bf16x8*)(sp + (vb * 16 + l15) * 64 + ks * 32 + g * 8);
        bf16x8 qF[2], qB[2];
#pragma unroll
        for (int ks = 0; ks < 2; ++ks) { qF[ks] = *(const bf16x8*)(qfw + tl * GS + ks * 32 + g * 8); qB[ks] = *(const bf16x8*)(qbw + tl * GS + ks * 32 + g * 8); }
        f32x4 o[8];
#pragma unroll
        for (int vb = 0; vb < 8; ++vb) o[vb] = (f32x4){0.f, 0.f, 0.f, 0.f};
        f32x4 at[4];
#pragma unroll
        for (int sb = 0; sb < 4; ++sb) {
            const bf16_t* kn = kng + (sb * 16 + l15) * GS + g * 8; const bf16_t* kp = kps + (sb * 16 + l15) * GS + g * 8;
            f32x4 ca = {0.f, 0.f, 0.f, 0.f}, an = {0.f, 0.f, 0.f, 0.f};
            ca = mfma16(*(const bf16x8*)kn, qF[0], ca); ca = mfma16(*(const bf16x8*)(kn + 32), qF[1], ca);
            an = mfma16(*(const bf16x8*)kp, qB[0], an); an = mfma16(*(const bf16x8*)(kp + 32), qB[1], an);
#pragma unroll
            for (int j = 0; j < 4; ++j) { const int sx = sb * 16 + 4 * g + j; at[sb][j] = (sx <= tl) ? ca[j] : an[j]; }
        }
#pragma unroll
        for (int kb = 0; kb < 2; ++kb) {
            u32x4 pw; pw.x = pk2(at[2 * kb][0], at[2 * kb][1]); pw.y = pk2(at[2 * kb][2], at[2 * kb][3]); pw.z = pk2(at[2 * kb + 1][0], at[2 * kb + 1][1]); pw.w = pk2(at[2 * kb + 1][2], at[2 * kb + 1][3]);
            const bf16x8 pf = __builtin_bit_cast(bf16x8, pw);
#pragma unroll
            for (int vb = 0; vb < 8; ++vb) {
                const s16x4 a0 = tr_read(vl + kb * 8192 + voff[vb]), a1 = tr_read(vl + kb * 8192 + 4096 + voff[vb]);
                o[vb] = mfma16(__builtin_shufflevector(a0, a1, 0, 1, 2, 3, 4, 5, 6, 7), pf, o[vb]);
            }
        }
#pragma unroll
        for (int vb = 0; vb < 8; ++vb) { o[vb] = mfma16(sf[vb][0], qF[0], o[vb]); o[vb] = mfma16(sf[vb][1], qF[1], o[vb]); }
        float ss = 0.f;
#pragma unroll
        for (int vb = 0; vb < 8; ++vb)
#pragma unroll
            for (int j = 0; j < 4; ++j) ss += o[vb][j] * o[vb][j];
        ss = sum_rows4(ss);
        const float rs = __builtin_amdgcn_rsqf(ss * (1.f / 128.f) + 1e-6f);
#pragma unroll
        for (int vb = 0; vb < 8; ++vb) {
            const int v0 = vb * 16 + 4 * g;
            const f32x4 gn = gnv[vb];
            const float y0 = o[vb][0] * rs * gn[0] * siluf_(bflo(gt[vb].x)), y1 = o[vb][1] * rs * gn[1] * siluf_(bfhi(gt[vb].x));
            const float y2 = o[vb][2] * rs * gn[2] * siluf_(bflo(gt[vb].y)), y3 = o[vb][3] * rs * gn[3] * siluf_(bfhi(gt[vb].y));
            u32x2 ov; ov.x = pk2(y0, y1); ov.y = pk2(y2, y3);
            *(u32x2*)(mix + trow * DM + 512 + h * 128 + v0) = ov;
        }
    }
    lds_barrier();
#undef GLA_PF_OUT
}

#define XB_TMO      128
#define XB_XCNT(j)  (256  + 64 * (j))
#define XB_XSUB(j)  (1280 + 64 * (j))
#define XB_XGEN(j)  (2304 + 64 * (j))
#define XB_TOP      3328
#define XB_TOPGEN   3392
#define XCD_BAR_WORDS 3456
#define XB_SPIN_CAP (1u << 18)
__device__ __forceinline__ unsigned xb_ld(unsigned* p)              { return __hip_atomic_load(p, __ATOMIC_RELAXED, __HIP_MEMORY_SCOPE_AGENT); }
__device__ __forceinline__ unsigned xb_add(unsigned* p, unsigned v) { return __hip_atomic_fetch_add(p, v, __ATOMIC_RELAXED, __HIP_MEMORY_SCOPE_AGENT); }
__device__ __forceinline__ unsigned xb_xcc_id() { return (unsigned)__builtin_amdgcn_s_getreg((3 << 11) | 20) & 0xFu; }
#define XB_SPIN(cond, bar) do { unsigned _sp = 0; while (cond) { __builtin_amdgcn_s_sleep(1); \
    if ((++_sp & 255u) == 0u) { if (xb_ld(&(bar)[XB_TMO])) break; if (_sp > XB_SPIN_CAP) { atomicAdd(&(bar)[XB_TMO], 1u); break; } } } } while (0)
struct XcdBarrier { unsigned* bar; unsigned x; volatile PG8_LAS unsigned* st; };
__device__ __forceinline__ XcdBarrier xcd_barrier_post(unsigned* bar, volatile PG8_LAS unsigned* st) {
    XcdBarrier b; b.bar = bar; b.x = xb_xcc_id(); b.st = st;
    if (threadIdx.x == 0) (void)xb_add(&bar[XB_XCNT(b.x)], 1u);
    return b;
}
__device__ __forceinline__ void xcd_barrier_complete(unsigned* bar, unsigned x, unsigned& nloc, unsigned& nx) {
    const unsigned G = gridDim.x * gridDim.y * gridDim.z;
    unsigned sum, cnt, mine, sp = 0u;
    for (;;) {
        sum = 0u; cnt = 0u; mine = 0u;
#pragma unroll
        for (unsigned j = 0; j < 16; ++j) { const unsigned c = xb_ld(&bar[XB_XCNT(j)]); sum += c; cnt += (c > 0u) ? 1u : 0u; mine = (j == x) ? c : mine; }
        if (sum == G) break;
        __builtin_amdgcn_s_sleep(1);
        if ((++sp & 255u) == 0u) { if (xb_ld(&bar[XB_TMO])) break; if (sp > XB_SPIN_CAP) { atomicAdd(&bar[XB_TMO], 1u); break; } }
    }
    nloc = mine > 0u ? mine : 1u; nx = cnt > 0u ? cnt : 1u;
}
__device__ __forceinline__ void xcd_barrier(const XcdBarrier& b) {
    asm volatile("s_waitcnt vmcnt(0)" ::: "memory");
    __syncthreads();
    if (threadIdx.x == 0) {
        unsigned* bar = b.bar;
        __builtin_amdgcn_s_waitcnt(0);
        unsigned nloc = b.st[0], nx = b.st[1];
        if (nloc == 0u) { xcd_barrier_complete(bar, b.x, nloc, nx); b.st[0] = nloc; b.st[1] = nx; }
        const unsigned old = xb_add(&bar[XB_XSUB(b.x)], 1u);
        const unsigned gen = old / nloc;
        if (old + 1u == (gen + 1u) * nloc) {
            __builtin_amdgcn_fence(__ATOMIC_RELEASE, "agent");
            asm volatile("s_waitcnt vmcnt(0)" ::: "memory");
            const unsigned og = xb_add(&bar[XB_TOP], 1u);
            const unsigned tg = og / nx;
            if (og + 1u == (tg + 1u) * nx) xb_add(&bar[XB_TOPGEN], 1u);
            else XB_SPIN(xb_ld(&bar[XB_TOPGEN]) == tg, bar);
            __builtin_amdgcn_fence(__ATOMIC_ACQUIRE, "agent");
            xb_add(&bar[XB_XGEN(b.x)], 1u);
            asm volatile("s_waitcnt vmcnt(0)" ::: "memory");
        } else {
            XB_SPIN(xb_ld(&bar[XB_XGEN(b.x)]) == gen, bar);
            __builtin_amdgcn_fence(__ATOMIC_ACQUIRE, "agent");
            asm volatile("s_waitcnt vmcnt(0)" ::: "memory");
        }
    }
    __syncthreads();
}

__global__ void __launch_bounds__(NTHR, 2) fwd_megakernel(Params P) {
    extern __shared__ __attribute__((aligned(16))) unsigned char lds[];
    cg::grid_group grid = cg::this_grid();
    const int tid = threadIdx.x, wave = tid >> 6, lane = tid & 63;
    unsigned char* ws = P.ws;
    bf16_t* proj = (bf16_t*)(ws + WS_PROJ); bf16_t* mix = (bf16_t*)(ws + WS_MIX); bf16_t* KVB = (bf16_t*)(ws + WS_KV); float* DEC = (float*)(ws + WS_DEC);
    const int G = gridDim.x;
    { volatile PG8_LAS unsigned* z = (volatile PG8_LAS unsigned*)((PG8_LAS unsigned char*)lds + LDS_BYTES - 16); if (tid < 4) z[tid] = 0u; }
    __syncthreads();
    const XcdBarrier xbar = xcd_barrier_post((unsigned*)(ws + WS_BAR), (volatile PG8_LAS unsigned*)((PG8_LAS unsigned char*)lds + LDS_BYTES - 16));
    if (P.ws == nullptr) grid.sync();

    prep_phase(P, lds);
    xcd_barrier(xbar);
    {
        pg8::Gemm gm{(const bf16_t*)(ws + WS_HBF), (const bf16_t*)(ws + WS_WIN), T_TOK, 3584, DM}; pg8::StaticOrder S; S.init(T_TOK, 3584, G, (int)blockIdx.x);
        EpiBf16 E{proj, NPROJ, NPROJ};
        pg8::gemm_phase<EpiBf16, pg8::StaticOrder, true, true>((PG8_LAS unsigned char*)lds, gm, S, E);
    }
    {
        const int lane_ = tid & 63, l15 = lane_ & 15, g4 = lane_ >> 4;
        const bf16_t* hb = (const bf16_t*)(ws + WS_HBF); const bf16_t* wl = (const bf16_t*)(ws + WS_WIN) + (size_t)3584 * DM;
        for (int rg = blockIdx.x * NWAVES + (tid >> 6); rg < T_TOK / 16; rg += G * NWAVES) {
            const bf16_t* ap = hb + (size_t)(rg * 16 + l15) * DM + g4 * 8; const bf16_t* bp = wl + (size_t)l15 * DM + g4 * 8;
            f32x4 acc0 = {0.f, 0.f, 0.f, 0.f}, acc1 = {0.f, 0.f, 0.f, 0.f};
#pragma unroll 8
            for (int ks = 0; ks < 32; ks += 2) {
                acc0 = mfma16(*(const bf16x8*)(bp + ks * 32), *(const bf16x8*)(ap + ks * 32), acc0);
                acc1 = mfma16(*(const bf16x8*)(bp + ks * 32 + 32), *(const bf16x8*)(ap + ks * 32 + 32), acc1);
            }
            const f32x4 r = acc0 + acc1;
            u32x2 o; o.x = pk2(r[0], r[1]); o.y = pk2(r[2], r[3]);
            *(u32x2*)(proj + (size_t)(rg * 16 + l15) * NPROJ + C_LR + 4 * g4) = o;
        }
    }
    xcd_barrier(xbar);
#ifndef NO_ATTN
    for (int rep = 0; rep < DUP_ATTN; ++rep)
    for (int u0 = blockIdx.x; u0 < 256; u0 += G) { const int u = (G == 256) ? ((u0 & 7) * 32 + (u0 >> 3)) : u0;
        attn_unit(proj, P.rel_bias, mix, lds, u >> 5, (u >> 2) & 7, (u & 3) * 16, 16); }
#endif
    for (int rep = 0; rep < DUP_KV; ++rep) gla_kv_phase(P, proj, KVB, DEC, (bf16_t*)(ws + WS_EG), lds);
    xcd_barrier(xbar);
#ifndef DUP_SCAN
#define DUP_SCAN 1
#endif
    for (int rep = 0; rep < DUP_SCAN; ++rep)
    for (int e = blockIdx.x * NTHR + tid; e < 32 * 2048; e += G * NTHR) {
        const int bh = e >> 11, vd = (e & 2047) * 4, d = vd & 63;
        const bf16_t* __restrict__ kvp = KVB + (size_t)bh * 64 * 8192 + vd; const float* __restrict__ dp = DEC + (size_t)bh * 64 * 64 + d;
        bf16_t* __restrict__ spo = (bf16_t*)(ws + WS_SPREV) + (size_t)bh * 64 * 8192 + vd;
        f32x4 stt = {0.f, 0.f, 0.f, 0.f};
#pragma unroll 1
        for (int c0 = 0; c0 < 64; c0 += 8) {
            u32x2 kv[8]; f32x4 dc[8];
#pragma unroll
            for (int u = 0; u < 8; ++u) { kv[u] = *(const u32x2*)(kvp + (size_t)(c0 + u) * 8192); dc[u] = *(const f32x4*)(dp + (c0 + u) * 64); }
#pragma unroll
            for (int u = 0; u < 8; ++u) { u32x2 o; o.x = pk2(stt[0], stt[1]); o.y = pk2(stt[2], stt[3]); *(u32x2*)(spo + (size_t)(c0 + u) * 8192) = o;
                const f32x4 kf = {bflo(kv[u].x), bfhi(kv[u].x), bflo(kv[u].y), bfhi(kv[u].y)}; stt = dc[u] * stt + kf; }
        }
    }
    xcd_barrier(xbar);
    for (int rep = 0; rep < DUP_OUT; ++rep) gla_out_phase(P, proj, (const bf16_t*)(ws + WS_SPREV), (const bf16_t*)(ws + WS_EG), mix, lds);
    xcd_barrier(xbar);
    {
        pg8::Gemm gm{mix, (const bf16_t*)(ws + WS_WOUT), T_TOK, DM, DM}; pg8::StaticOrder S; S.init(T_TOK, DM, G, (int)blockIdx.x);
        EpiRes E{(const bf16_t*)(ws + WS_HBF), (bf16_t*)(ws + WS_R32)};
        pg8::gemm_phase<EpiRes, pg8::StaticOrder, true, true>((PG8_LAS unsigned char*)lds, gm, S, E);
    }
    {
        pg8::Gemm gm{(const bf16_t*)(ws + WS_PBF), (const bf16_t*)(ws + WS_WP), T_TOK, DM, DPLE}; pg8::StaticOrder S; S.init(T_TOK, DM, G, (int)blockIdx.x);
        EpiBf16 E{proj, DM, DM};
        pg8::gemm_phase<EpiBf16, pg8::StaticOrder, true, true>((PG8_LAS unsigned char*)lds, gm, S, E);
    }
    xcd_barrier(xbar);
    {
        pg8::Gemm gm{(const bf16_t*)(ws + WS_R32), (const bf16_t*)(ws + WS_WG), T_TOK, DM, DM}; pg8::StaticOrder S; S.init(T_TOK, DM, G, (int)blockIdx.x);
        EpiGate E{P.b_ple_gate, proj, (const bf16_t*)(ws + WS_R32), (bf16_t*)(ws + WS_KV)};
        pg8::gemm_phase<EpiGate, pg8::StaticOrder, true, true>((PG8_LAS unsigned char*)lds, gm, S, E);
    }
    xcd_barrier(xbar);
    {
        const bf16_t* ybf = (const bf16_t*)(ws + WS_KV);
        f32x4 gg[4], bb[4];
#pragma unroll
        for (int j = 0; j < 4; ++j) { gg[j] = ((const f32x4*)P.ln_g)[lane + 64 * j]; bb[j] = ((const f32x4*)P.ln_b)[lane + 64 * j]; }
        for (int m = blockIdx.x * NWAVES + wave; m < T_TOK; m += 2 * G * NWAVES) {
            const int m2 = m + G * NWAVES;
            const bool has2 = m2 < T_TOK;
            const u32x2* yr = (const u32x2*)(ybf + (size_t)m * DM) + lane;
            const u32x2* yr2 = (const u32x2*)(ybf + (size_t)(has2 ? m2 : m) * DM) + lane;
            u32x2 t[4], t2[4];
#pragma unroll
            for (int j = 0; j < 4; ++j) { t[j] = __builtin_nontemporal_load(&yr[64 * j]); t2[j] = __builtin_nontemporal_load(&yr2[64 * j]); }
            f32x4 v[4], w[4]; float s = 0.f, sb = 0.f;
#pragma unroll
            for (int j = 0; j < 4; ++j) { v[j] = (f32x4){bflo(t[j].x), bfhi(t[j].x), bflo(t[j].y), bfhi(t[j].y)}; s += (v[j].x + v[j].y) + (v[j].z + v[j].w);
                                          w[j] = (f32x4){bflo(t2[j].x), bfhi(t2[j].x), bflo(t2[j].y), bfhi(t2[j].y)}; sb += (w[j].x + w[j].y) + (w[j].z + w[j].w); }
            const float mean = wave_sum(s) * (1.f / DM), meanb = wave_sum(sb) * (1.f / DM); float s2 = 0.f, s2b = 0.f;
#pragma unroll
            for (int j = 0; j < 4; ++j) { v[j] = v[j] - mean; s2 += (v[j].x * v[j].x + v[j].y * v[j].y) + (v[j].z * v[j].z + v[j].w * v[j].w);
                                          w[j] = w[j] - meanb; s2b += (w[j].x * w[j].x + w[j].y * w[j].y) + (w[j].z * w[j].z + w[j].w * w[j].w); }
            const float rstd = __builtin_amdgcn_rsqf(wave_sum(s2) * (1.f / DM) + 1e-5f), rstdb = __builtin_amdgcn_rsqf(wave_sum(s2b) * (1.f / DM) + 1e-5f);
            f32x4* orow = (f32x4*)(P.out + (size_t)m * DM) + lane;
#pragma unroll
            for (int j = 0; j < 4; ++j) __builtin_nontemporal_store(v[j] * rstd * gg[j] + bb[j], &orow[64 * j]);
            if (has2) { f32x4* orow2 = (f32x4*)(P.out + (size_t)m2 * DM) + lane;
#pragma unroll
                for (int j = 0; j < 4; ++j) __builtin_nontemporal_store(w[j] * rstdb * gg[j] + bb[j], &orow2[64 * j]); }
        }
    }
}

extern "C" void kernel_launch(void* const* d_in, const int* in_sizes, int n_in, void* d_out, int out_size, void* d_ws, size_t ws_size, hipStream_t stream) {
    static int grid_blocks = 0;
    if (grid_blocks == 0) {
        if (n_in != 15 || out_size != T_TOK * DM || ws_size < WS_END) { fprintf(stderr, "kernel_launch: unexpected shapes (n_in %d out %d ws %zu need %zu)\n", n_in, out_size, ws_size, (size_t)WS_END); grid_blocks = -1; return; }
        int dev = 0, cus = 0, per_cu = 0;
        hipGetDevice(&dev); hipDeviceGetAttribute(&cus, hipDeviceAttributeMultiprocessorCount, dev);
        if (hipFuncSetAttribute((const void*)fwd_megakernel, hipFuncAttributeMaxDynamicSharedMemorySize, LDS_BYTES) != hipSuccess) { fprintf(stderr, "kernel_launch: hipFuncSetAttribute failed\n"); grid_blocks = -1; return; }
        if (hipOccupancyMaxActiveBlocksPerMultiprocessor(&per_cu, (const void*)fwd_megakernel, NTHR, LDS_BYTES) != hipSuccess || per_cu < 1) { fprintf(stderr, "kernel_launch: occupancy query gave %d\n", per_cu); per_cu = 1; }
        (void)hipGetLastError();
        grid_blocks = cus;
    }
    if (grid_blocks < 0) return;
    Params P{};
    P.x = (const float*)d_in[0]; P.p = (const float*)d_in[1]; P.ln_in_g = (const float*)d_in[2]; P.ln_in_b = (const float*)d_in[3]; P.w_in = (const float*)d_in[4];
    P.w_gla_gate = (const float*)d_in[5]; P.b_gla_gate = (const float*)d_in[6]; P.rel_bias = (const float*)d_in[7]; P.gla_norm_g = (const float*)d_in[8];
    P.w_out = (const float*)d_in[9]; P.w_ple = (const float*)d_in[10]; P.w_ple_gate = (const float*)d_in[11]; P.b_ple_gate = (const float*)d_in[12];
    P.ln_g = (const float*)d_in[13]; P.ln_b = (const float*)d_in[14]; P.out = (float*)d_out; P.ws = (unsigned char*)d_ws;
    if (hipMemsetAsync((unsigned char*)d_ws + WS_BAR, 0, 16384, stream) != hipSuccess) { fprintf(stderr, "kernel_launch: memset failed\n"); return; }
    void* args[] = {&P};
    hipError_t e = hipLaunchCooperativeKernel((const void*)fwd_megakernel, dim3(grid_blocks), dim3(NTHR), args, LDS_BYTES, stream);
    if (e != hipSuccess) fprintf(stderr, "cooperative launch failed: %s (grid %d)\n", hipGetErrorString(e), grid_blocks);
}
```

```cpp
#include <hip/hip_runtime.h>
#include <hip/hip_cooperative_groups.h>
#include <cstdio>
#include <cstdint>
namespace cg = cooperative_groups;
#ifndef DUP_ATTN
#define DUP_ATTN 1
#endif
#ifndef DUP_KV
#define DUP_KV 1
#endif
#ifndef DUP_OUT
#define DUP_OUT 1
#endif
#ifndef DUP_G1
#define DUP_G1 1
#endif
__device__ __forceinline__ int opaque_tid_g() { int t = threadIdx.x; asm volatile("" : "+v"(t)); return t; }
namespace pg8 {
#define PG8_LAS __attribute__((address_space(3)))
typedef unsigned short bf16_t;
typedef short bf16x8 __attribute__((ext_vector_type(8)));
typedef float f32x4 __attribute__((ext_vector_type(4)));
typedef unsigned u32x4 __attribute__((ext_vector_type(4)));
constexpr int BM = 256, BK = 64, HALF = 128, HTB = HALF * BK * 2  , STAGE_BYTES = 8 * HTB, NXCD = 8, WGM = 8;

__host__ __device__ __forceinline__ int lds_byte(int r, int c) { const int st = (r >> 4) * 2 + (c >> 5), rr = r & 15, cc = c & 31, ob = rr * 64 + cc * 2; return st * 1024 + (ob ^ (((ob >> 9) & 1) << 5)); }
__host__ __device__ __forceinline__ void stage_rc(int b, int& R, int& C) { const int st = b / 1024, sb = b % 1024, swz = sb ^ (((sb >> 9) & 1) << 5); R = (st >> 1) * 16 + swz / 64; C = (st & 1) * 32 + (swz % 64) / 2; }
__host__ __device__ __forceinline__ int perm32(int rho) { const int n = rho >> 4, i = rho & 15; return 8 * (i >> 2) + 4 * n + (i & 3); }

struct Unit { int pm, pn; };
struct Gemm { const bf16_t* A; const bf16_t* Bt; int M, N, K; };

struct StaticOrder {
    int nM, nN, nwg, G, c;
    __host__ __device__ void init(int M, int N, int G_, int c_) { nM = M / BM; nN = N / BM; nwg = nM * nN; G = G_; c = c_; }
    __host__ __device__ bool next(int i, Unit& u) const {
        const long L = (long)i * G + c; if (L >= nwg) return false;
        int wgid = (int)L; { const int q = nwg / NXCD, r = nwg % NXCD, xcd = wgid % NXCD, off = wgid / NXCD; wgid = (xcd < r ? xcd * (q + 1) : r * (q + 1) + (xcd - r) * q) + off; }
        const int nig = WGM * nN, gid = wgid / nig, fm = gid * WGM, gsz = (nM - fm) < WGM ? (nM - fm) : WGM;
        u.pm = fm + ((wgid % nig) % gsz); u.pn = (wgid % nig) / gsz; return true;
    }
    __device__ __forceinline__ void a_ready(const Unit&) const {}
    __device__ __forceinline__ void done(const Unit&) const {}
};

template <class Epi, class Sched, bool ALIGN_EPI = false, bool SP2 = false>
__device__ __forceinline__ void gemm_phase(PG8_LAS unsigned char* lds, const Gemm g, const Sched& S, const Epi& E) {
    const int tid = opaque_tid_g(), wid = __builtin_amdgcn_readfirstlane(tid >> 6), lane = tid & 63, wr = wid >> 2, wc = wid & 3, fr = lane & 15, fq = lane >> 4;
    const int K = g.K, nt = K / BK;
    unsigned voffA[2], voffB[2];
#pragma unroll
    for (int i = 0; i < 2; ++i) { int R, C; stage_rc(tid * 16 + i * 8192, R, C); const int Rb = Epi::PERM ? ((R & ~31) + perm32(R & 31)) : R;
        voffA[i] = (unsigned)(R * K + C) * 2u; voffB[i] = (unsigned)(Rb * K + C) * 2u; }
    const size_t kstep = (size_t)(BK * 2);
    const size_t hstep = (size_t)HALF * K * 2;
    const size_t tstep = 2 * hstep;
    const unsigned ldsw = (unsigned)wid * 1024u;
    const int aoff = lds_byte(wr * 64 + fr, fq * 8), boff = lds_byte(wc * 32 + fr, fq * 8);
#define PG8_SA(b, h) (((b) * 2 + (h)) * HTB)
#define PG8_SB(b, h) ((4 + (b) * 2 + (h)) * HTB)
#define PG8_STAGE(bufoff, gbase, voff) do { _Pragma("unroll") for (int _i = 0; _i < 2; ++_i) \
        __builtin_amdgcn_global_load_lds((const unsigned*)((const char*)(gbase) + (voff)[_i]), (PG8_LAS unsigned*)(lds + (bufoff) + ldsw + _i * 8192), 16, 0, 0); } while (0)
#define PG8_LDA(dst, b, h) do { _Pragma("unroll") for (int m = 0; m < 4; ++m) _Pragma("unroll") for (int k = 0; k < 2; ++k) dst[m][k] = *(const PG8_LAS bf16x8*)(lds + PG8_SA(b, h) + aoff + m * 2048 + k * 1024); } while (0)
#define PG8_LDB(dst, b, h) do { _Pragma("unroll") for (int n = 0; n < 2; ++n) _Pragma("unroll") for (int k = 0; k < 2; ++k) dst[n][k] = *(const PG8_LAS bf16x8*)(lds + PG8_SB(b, h) + boff + n * 2048 + k * 1024); } while (0)
#define PG8_MMA(ai, bj, At, Bt) do { __builtin_amdgcn_s_setprio(1); _Pragma("unroll") for (int m = 0; m < 4; ++m) _Pragma("unroll") for (int n = 0; n < 2; ++n) _Pragma("unroll") for (int k = 0; k < 2; ++k) \
        acc[ai][bj][m][n] = __builtin_amdgcn_mfma_f32_16x16x32_bf16(Bt[n][k], At[m][k], acc[ai][bj][m][n], 0, 0, 0); __builtin_amdgcn_s_setprio(0); } while (0)
#define PG8_WAIT_V(n) asm volatile("s_waitcnt vmcnt(" #n ")" ::: "memory")
#define PG8_WAIT_L(n) asm volatile("s_waitcnt lgkmcnt(" #n ")" ::: "memory")
#define PG8_BAR __builtin_amdgcn_s_barrier()
#define PG8_SCHED __builtin_amdgcn_sched_barrier(0)
    Unit cur, nxt; int ui = 0;
    if (!S.next(0, cur)) return;
    f32x4 acc[2][2][4][2];
#pragma unroll
    for (int a = 0; a < 2; ++a)
#pragma unroll
        for (int b = 0; b < 2; ++b)
#pragma unroll
            for (int m = 0; m < 4; ++m)
#pragma unroll
                for (int n = 0; n < 2; ++n) acc[a][b][m][n] = (f32x4){0.f, 0.f, 0.f, 0.f};
    bf16x8 At[4][2], B0[2][2], B1[2][2];
    const char* cA = (const char*)g.A + (size_t)cur.pm * tstep; const char* cB = (const char*)g.Bt + (size_t)cur.pn * tstep;
    S.a_ready(cur);
    if constexpr (SP2) {
        PG8_STAGE(PG8_SB(0, 0), cB, voffB); PG8_STAGE(PG8_SB(0, 1), cB + hstep, voffB); PG8_STAGE(PG8_SA(0, 0), cA, voffA); PG8_STAGE(PG8_SA(0, 1), cA + hstep, voffA);
        if (wr == 1) PG8_BAR;
        PG8_WAIT_V(2); PG8_BAR;
        PG8_STAGE(PG8_SB(1, 0), cB + kstep, voffB); PG8_STAGE(PG8_SA(1, 0), cA + kstep, voffA); PG8_STAGE(PG8_SB(1, 1), cB + hstep + kstep, voffB);
        PG8_WAIT_V(6); PG8_BAR;
    } else {
        PG8_STAGE(PG8_SB(0, 0), cB, voffB); PG8_STAGE(PG8_SA(0, 0), cA, voffA); PG8_STAGE(PG8_SB(0, 1), cB + hstep, voffB); PG8_STAGE(PG8_SA(0, 1), cA + hstep, voffA);
        if (wr == 1) PG8_BAR;
        PG8_WAIT_V(4); PG8_BAR;
        PG8_STAGE(PG8_SB(1, 0), cB + kstep, voffB); PG8_STAGE(PG8_SA(1, 0), cA + kstep, voffA); PG8_STAGE(PG8_SB(1, 1), cB + hstep + kstep, voffB);
        PG8_WAIT_V(6); PG8_BAR;
    }
    for (;;) {
        const bool has_next = S.next(ui + 1, nxt);
        const char* nA = has_next ? (const char*)g.A + (size_t)nxt.pm * tstep : cA; const char* nB = has_next ? (const char*)g.Bt + (size_t)nxt.pn * tstep : cB;
        for (int t = 0; t < nt; t += 2) {
            const bool last = (t == nt - 2);
            const char* a1 = cA + (size_t)(t + 1) * kstep;
            const char* a2 = last ? nA : cA + (size_t)(t + 2) * kstep; const char* b2 = last ? nB : cB + (size_t)(t + 2) * kstep;
            const char* a3 = a2 + kstep; const char* b3 = b2 + kstep;
            if (last && has_next) S.a_ready(nxt);
            if constexpr (SP2) {
            PG8_LDB(B0, 0, 0); PG8_LDB(B1, 0, 1); PG8_SCHED; PG8_LDA(At, 0, 0); PG8_STAGE(PG8_SA(1, 1), a1 + hstep, voffA);
            PG8_WAIT_V(8); PG8_WAIT_L(0); PG8_BAR; PG8_MMA(0, 0, At, B0); PG8_MMA(0, 1, At, B1); PG8_BAR; PG8_SCHED;
            PG8_LDA(At, 0, 1); PG8_STAGE(PG8_SB(0, 0), b2, voffB); PG8_STAGE(PG8_SB(0, 1), b2 + hstep, voffB); PG8_STAGE(PG8_SA(0, 0), a2, voffA);
            PG8_WAIT_V(8); PG8_WAIT_L(0); PG8_BAR; PG8_MMA(1, 0, At, B0); PG8_MMA(1, 1, At, B1); PG8_BAR; PG8_SCHED;
            PG8_LDB(B0, 1, 0); PG8_LDB(B1, 1, 1); PG8_SCHED; PG8_LDA(At, 1, 0); PG8_STAGE(PG8_SA(0, 1), a2 + hstep, voffA);
            PG8_WAIT_V(8); PG8_WAIT_L(0); PG8_BAR; PG8_MMA(0, 0, At, B0); PG8_MMA(0, 1, At, B1); PG8_BAR; PG8_SCHED;
            PG8_LDA(At, 1, 1); PG8_STAGE(PG8_SB(1, 0), b3, voffB); PG8_STAGE(PG8_SB(1, 1), b3 + hstep, voffB); PG8_STAGE(PG8_SA(1, 0), a3, voffA);
            PG8_WAIT_V(8); PG8_WAIT_L(0); PG8_BAR; PG8_MMA(1, 0, At, B0); PG8_MMA(1, 1, At, B1); PG8_BAR; PG8_SCHED;
            } else {
            PG8_LDB(B0, 0, 0); PG8_SCHED; PG8_LDA(At, 0, 0); PG8_STAGE(PG8_SA(1, 1), a1 + hstep, voffA);
            PG8_WAIT_L(8); PG8_BAR; PG8_WAIT_L(0); PG8_MMA(0, 0, At, B0); PG8_BAR; PG8_SCHED;
            PG8_LDB(B1, 0, 1); PG8_STAGE(PG8_SB(0, 0), b2, voffB);
            PG8_BAR; PG8_WAIT_L(0); PG8_MMA(0, 1, At, B1); PG8_BAR;
            PG8_LDA(At, 0, 1); PG8_STAGE(PG8_SA(0, 0), a2, voffA);
            PG8_BAR; PG8_WAIT_L(0); PG8_MMA(1, 0, At, B0); PG8_BAR; PG8_SCHED;
            PG8_STAGE(PG8_SB(0, 1), b2 + hstep, voffB);
            PG8_WAIT_V(6); PG8_BAR; PG8_MMA(1, 1, At, B1); PG8_BAR;
            PG8_LDB(B0, 1, 0); PG8_SCHED; PG8_LDA(At, 1, 0); PG8_STAGE(PG8_SA(0, 1), a2 + hstep, voffA);
            PG8_WAIT_L(8); PG8_BAR; PG8_WAIT_L(0); PG8_MMA(0, 0, At, B0); PG8_BAR; PG8_SCHED;
            PG8_LDB(B1, 1, 1); PG8_STAGE(PG8_SB(1, 0), b3, voffB);
            PG8_BAR; PG8_WAIT_L(0); PG8_MMA(0, 1, At, B1); PG8_BAR;
            PG8_LDA(At, 1, 1); PG8_STAGE(PG8_SA(1, 0), a3, voffA);
            PG8_BAR; PG8_WAIT_L(0); PG8_MMA(1, 0, At, B0); PG8_BAR; PG8_SCHED;
            PG8_STAGE(PG8_SB(1, 1), b3 + hstep, voffB);
            PG8_WAIT_V(6); PG8_BAR; PG8_MMA(1, 1, At, B1); PG8_BAR;
            }
        }
        if constexpr (ALIGN_EPI) { if (wr == 0) PG8_BAR; }
        if constexpr (!Epi::AFTER_DRAIN) { E(acc, cur, wr, wc, fr, fq); S.done(cur); }
        if (!has_next) break;
#pragma unroll
        for (int a = 0; a < 2; ++a)
#pragma unroll
            for (int b = 0; b < 2; ++b)
#pragma unroll
                for (int m = 0; m < 4; ++m)
#pragma unroll
                    for (int n = 0; n < 2; ++n) acc[a][b][m][n] = (f32x4){0.f, 0.f, 0.f, 0.f};
        cur = nxt; cA = nA; cB = nB; ++ui;
        if constexpr (ALIGN_EPI) { if (wr == 1) PG8_BAR; }
    }
    PG8_WAIT_V(0);
    if constexpr (!ALIGN_EPI) { if (wr == 0) PG8_BAR; }
    PG8_BAR;
    if constexpr (Epi::AFTER_DRAIN) { E.fused(acc, cur, wr, wc, fr, fq, lds, wid, lane); S.done(cur); }
#undef PG8_SA
#undef PG8_SB
#undef PG8_STAGE
#undef PG8_LDA
#undef PG8_LDB
#undef PG8_MMA
#undef PG8_WAIT_V
#undef PG8_WAIT_L
#undef PG8_BAR
#undef PG8_SCHED
}
}

using pg8::bf16_t; using pg8::bf16x8; using pg8::f32x4; using pg8::u32x4;
typedef unsigned u32x2 __attribute__((ext_vector_type(2)));
constexpr int T_TOK = 32768, DM = 1024, SEQ = 4096, NPROJ = 3600, NPAD = 3840, DPLE = 256;
constexpr int C_AQ = 0, C_AK = 512, C_AV = 1024, C_AG = 1536, C_GQ = 2048, C_GK = 2304, C_GV = 2560, C_GG = 3072, C_LR = 3584;
constexpr float ALPHA = 1.189207115002721f;
constexpr int NTHR = 512, NWAVES = 8;
constexpr int LDS_BYTES = 156 * 1024;
constexpr size_t WS_WIN = 0;
constexpr size_t WS_WOUT = WS_WIN + (size_t)NPAD * DM * 2;
constexpr size_t WS_WG = WS_WOUT + (size_t)DM * DM * 2;
constexpr size_t WS_WP = WS_WG + (size_t)DM * DM * 2;
constexpr size_t WS_STATS = WS_WP + (size_t)DM * DPLE * 2;
constexpr size_t WS_DEC = WS_STATS + (size_t)T_TOK * 8;
constexpr size_t WS_HBF = WS_DEC + (size_t)32 * 64 * 64 * 4;
constexpr size_t WS_PBF = WS_HBF + (size_t)T_TOK * DM * 2;
constexpr size_t WS_PROJ = WS_PBF + (size_t)T_TOK * DPLE * 2;
constexpr size_t WS_R32 = WS_PROJ + (size_t)T_TOK * DM * 2;
constexpr size_t WS_MIX = WS_PROJ + (size_t)T_TOK * NPROJ * 2;
constexpr size_t WS_KV = WS_MIX + (size_t)T_TOK * DM * 2;
constexpr size_t WS_SPREV = WS_KV + (size_t)32 * 64 * 128 * 64 * 4;
constexpr size_t WS_EG = WS_SPREV + (size_t)32 * 64 * 128 * 64 * 2;
constexpr size_t WS_BAR = WS_EG + (size_t)2048 * 4096 * 2;
constexpr size_t WS_END = WS_BAR + 16384;

struct Params {
    const float* x; const float* p; const float* ln_in_g; const float* ln_in_b; const float* w_in; const float* w_gla_gate; const float* b_gla_gate;
    const float* rel_bias; const float* gla_norm_g; const float* w_out; const float* w_ple; const float* w_ple_gate; const float* b_ple_gate;
    const float* ln_g; const float* ln_b; float* out; unsigned char* ws;
};

typedef __bf16 bf16x2_hw __attribute__((ext_vector_type(2)));
typedef float f32x2_hw __attribute__((ext_vector_type(2)));
typedef short s16x4 __attribute__((ext_vector_type(4)));
__device__ __forceinline__ unsigned pk2(float lo, float hi) { f32x2_hw v = {lo, hi}; bf16x2_hw b = __builtin_convertvector(v, bf16x2_hw); return __builtin_bit_cast(unsigned, b); }
__device__ __forceinline__ unsigned f2bf(float f) { return pk2(f, 0.f) & 0xffffu; }
__device__ __forceinline__ s16x4 tr_read(PG8_LAS const unsigned char* p) { return __builtin_amdgcn_ds_read_tr16_b64_v4i16((PG8_LAS s16x4*)p); }
__device__ __forceinline__ float bflo(unsigned u) { return __builtin_bit_cast(float, u << 16); }
__device__ __forceinline__ float bfhi(unsigned u) { return __builtin_bit_cast(float, u & 0xffff0000u); }
__device__ __forceinline__ float bf2f(bf16_t v) { return __builtin_bit_cast(float, (unsigned)v << 16); }
__device__ __forceinline__ float wave_sum(float v) {
#pragma unroll
    for (int o = 1; o < 64; o <<= 1) v += __shfl_xor(v, o);
    return v;
}
__device__ __forceinline__ int opaque_tid() { int t = threadIdx.x; asm volatile("" : "+v"(t)); return t; }
__device__ __forceinline__ void lds_barrier() { asm volatile("s_waitcnt lgkmcnt(0)" ::: "memory"); __builtin_amdgcn_s_barrier(); asm volatile("" ::: "memory"); }
__device__ __forceinline__ float max_rows4(float v) {
    float a = v, b = v;
    asm("s_nop 1\n\tv_permlane16_swap_b32 %0, %1" : "+v"(a), "+v"(b));
    a = fmaxf(a, b); b = a;
    asm("s_nop 1\n\tv_permlane32_swap_b32 %0, %1" : "+v"(a), "+v"(b));
    return fmaxf(a, b);
}
__device__ __forceinline__ float sum_rows4(float v) {
    float a = v, b = v;
    asm("s_nop 1\n\tv_permlane16_swap_b32 %0, %1" : "+v"(a), "+v"(b));
    a = a + b; b = a;
    asm("s_nop 1\n\tv_permlane32_swap_b32 %0, %1" : "+v"(a), "+v"(b));
    return a + b;
}
__device__ __forceinline__ float sigmoidf_(float z) { return __builtin_amdgcn_rcpf(1.f + __expf(-z)); }
__device__ __forceinline__ float siluf_(float z) { return z * __builtin_amdgcn_rcpf(1.f + __expf(-z)); }
__device__ __forceinline__ f32x4 mfma16(bf16x8 a, bf16x8 b, f32x4 c) { return __builtin_amdgcn_mfma_f32_16x16x32_bf16(a, b, c, 0, 0, 0); }

__device__ __forceinline__ void transpose_item(const float* W, int K, int N, int nblk, bf16_t* WT, float* scr, int item, int lane) {
    const int kb = item / nblk, nb = item - kb * nblk, k0 = 64 * kb, n0 = 32 * nb;
    const int nn = n0 + (lane & 31);
#pragma unroll 8
    for (int i = 0; i < 32; ++i) { const int kk = 2 * i + (lane >> 5); scr[kk * 33 + (lane & 31)] = (nn < N) ? __builtin_nontemporal_load(&W[(size_t)(k0 + kk) * N + nn]) : 0.f; }
    asm volatile("s_waitcnt lgkmcnt(0)" ::: "memory");
    const int c = lane & 7;
#pragma unroll
    for (int j = 0; j < 4; ++j) { const int n = (lane >> 3) + 8 * j; const float* s = scr + (8 * c) * 33 + n;
        u32x4 o; o.x = pk2(s[0 * 33], s[1 * 33]); o.y = pk2(s[2 * 33], s[3 * 33]); o.z = pk2(s[4 * 33], s[5 * 33]); o.w = pk2(s[6 * 33], s[7 * 33]);
        *(u32x4*)(WT + (size_t)(n0 + n) * K + k0 + 8 * c) = o; }
    asm volatile("s_waitcnt lgkmcnt(0)" ::: "memory");
}

__device__ __forceinline__ void prep_phase(const Params& P, unsigned char* lds) {
    const int tid = threadIdx.x, wave = tid >> 6, lane = tid & 63;
    unsigned char* ws = P.ws;
    float* scr = (float*)(lds + wave * 16384);
    const int gw = blockIdx.x * NWAVES + wave, NGW = gridDim.x * NWAVES;
    constexpr int I_IN = (DM / 64) * (NPAD / 32), I_OUT = (DM / 64) * (DM / 32), I_P = (DPLE / 64) * (DM / 32);
    constexpr int NITEMS = I_IN + 2 * I_OUT + I_P;
    for (int it = gw; it < NITEMS; it += NGW) {
        int r = it;
        if (r < I_IN) { transpose_item(P.w_in, DM, NPROJ, NPAD / 32, (bf16_t*)(ws + WS_WIN), scr, r, lane); continue; } r -= I_IN;
        if (r < I_OUT) { transpose_item(P.w_out, DM, DM, DM / 32, (bf16_t*)(ws + WS_WOUT), scr, r, lane); continue; } r -= I_OUT;
        if (r < I_OUT) { transpose_item(P.w_ple_gate, DM, DM, DM / 32, (bf16_t*)(ws + WS_WG), scr, r, lane); continue; } r -= I_OUT;
        transpose_item(P.w_ple, DPLE, DM, DM / 32, (bf16_t*)(ws + WS_WP), scr, r, lane);
    }
    bf16_t* hbf = (bf16_t*)(ws + WS_HBF); float2* stats = (float2*)(ws + WS_STATS);
    f32x4 gg[4], bb[4];
#pragma unroll
    for (int j = 0; j < 4; ++j) { gg[j] = ((const f32x4*)P.ln_in_g)[lane + 64 * j]; bb[j] = ((const f32x4*)P.ln_in_b)[lane + 64 * j]; }
    for (int m = gw; m < T_TOK; m += NGW) {
        const f32x4* xr = (const f32x4*)(P.x + (size_t)m * DM) + lane;
        f32x4 v[4]; float s = 0.f;
#pragma unroll
        for (int j = 0; j < 4; ++j) { v[j] = __builtin_nontemporal_load(&xr[64 * j]); s += (v[j].x + v[j].y) + (v[j].z + v[j].w); }
        const float mean = wave_sum(s) * (1.f / DM); float s2 = 0.f;
#pragma unroll
        for (int j = 0; j < 4; ++j) { v[j] = v[j] - mean; s2 += (v[j].x * v[j].x + v[j].y * v[j].y) + (v[j].z * v[j].z + v[j].w * v[j].w); }
        const float rstd = __builtin_amdgcn_rsqf(wave_sum(s2) * (1.f / DM) + 1e-5f);
        u32x2* o8 = (u32x2*)(hbf + (size_t)m * DM) + lane;
#pragma unroll
        for (int j = 0; j < 4; ++j) { const f32x4 y = v[j] * rstd * gg[j] + bb[j]; u32x2 o; o.x = pk2(y.x, y.y); o.y = pk2(y.z, y.w); o8[64 * j] = o; }
        if (lane == 0) stats[m] = make_float2(mean, rstd);
    }
    bf16_t* pbf = (bf16_t*)(ws + WS_PBF);
    for (size_t i = (size_t)blockIdx.x * NTHR + tid; i < (size_t)T_TOK * DPLE / 8; i += (size_t)gridDim.x * NTHR) {
        const f32x4 a = __builtin_nontemporal_load(&((const f32x4*)P.p)[2 * i]), b = __builtin_nontemporal_load(&((const f32x4*)P.p)[2 * i + 1]);
        u32x4 o; o.x = pk2(a.x, a.y); o.y = pk2(a.z, a.w); o.z = pk2(b.x, b.y); o.w = pk2(b.z, b.w);
        ((u32x4*)pbf)[i] = o;
    }
}

struct EpiBf16 {
    static constexpr bool PERM = true, AFTER_DRAIN = false;
    bf16_t* O; int ldc; int ncols;
    __device__ __forceinline__ void operator()(const f32x4 (&acc)[2][2][4][2], const pg8::Unit& u, int wr, int wc, int fr, int fq) const {
        const int row0 = u.pm * 256 + wr * 64 + fr, col0 = u.pn * 256 + wc * 32 + 8 * fq;
#pragma unroll
        for (int ai = 0; ai < 2; ++ai)
#pragma unroll
            for (int m = 0; m < 4; ++m) { bf16_t* rowp = O + (size_t)(row0 + ai * 128 + m * 16) * ldc;
#pragma unroll
                for (int bj = 0; bj < 2; ++bj) { const int c = col0 + bj * 128;
                    if (c < ncols) { const f32x4 v0 = acc[ai][bj][m][0], v1 = acc[ai][bj][m][1];
                        u32x4 o; o.x = pk2(v0[0], v0[1]); o.y = pk2(v0[2], v0[3]); o.z = pk2(v1[0], v1[1]); o.w = pk2(v1[2], v1[3]);
                        *(u32x4*)(rowp + c) = o; } } }
    }
};
struct EpiRes {
    static constexpr bool PERM = true, AFTER_DRAIN = false;
    const bf16_t* hbf; bf16_t* rbf;
    __device__ __forceinline__ void operator()(const f32x4 (&acc)[2][2][4][2], const pg8::Unit& u, int wr, int wc, int fr, int fq) const {
        const int row0 = u.pm * 256 + wr * 64 + fr, col0 = u.pn * 256 + wc * 32 + 8 * fq;
#pragma unroll
        for (int bj = 0; bj < 2; ++bj) { const int c = col0 + bj * 128;
#pragma unroll
            for (int ai = 0; ai < 2; ++ai)
#pragma unroll
                for (int m = 0; m < 4; ++m) { const size_t row = (size_t)(row0 + ai * 128 + m * 16);
                    const u32x4 hh = *(const u32x4*)(hbf + row * DM + c);
                    const f32x4 a0 = acc[ai][bj][m][0], a1 = acc[ai][bj][m][1];
                    u32x4 o; o.x = pk2(bflo(hh.x) * ALPHA + a0[0], bfhi(hh.x) * ALPHA + a0[1]); o.y = pk2(bflo(hh.y) * ALPHA + a0[2], bfhi(hh.y) * ALPHA + a0[3]);
                    o.z = pk2(bflo(hh.z) * ALPHA + a1[0], bfhi(hh.z) * ALPHA + a1[1]); o.w = pk2(bflo(hh.w) * ALPHA + a1[2], bfhi(hh.w) * ALPHA + a1[3]);
                    *(u32x4*)(rbf + row * DM + c) = o; } }
    }
};
struct EpiGate {
    static constexpr bool PERM = true, AFTER_DRAIN = false;
    const float* bias; const bf16_t* ple; const bf16_t* rbf; bf16_t* ybf;
    __device__ __forceinline__ void operator()(const f32x4 (&acc)[2][2][4][2], const pg8::Unit& u, int wr, int wc, int fr, int fq) const {
        const int row0 = u.pm * 256 + wr * 64 + fr, col0 = u.pn * 256 + wc * 32 + 8 * fq;
#pragma unroll
        for (int bj = 0; bj < 2; ++bj) { const int c = col0 + bj * 128;
            const f32x4 b0 = *(const f32x4*)(bias + c), b1 = *(const f32x4*)(bias + c + 4);
#pragma unroll
            for (int ai = 0; ai < 2; ++ai)
#pragma unroll
                for (int m = 0; m < 4; ++m) { const size_t row = (size_t)(row0 + ai * 128 + m * 16);
                    const u32x4 rr = *(const u32x4*)(rbf + row * DM + c);
                    const u32x4 pl = *(const u32x4*)(ple + row * DM + c);
                    const f32x4 z0 = acc[ai][bj][m][0] + b0, z1 = acc[ai][bj][m][1] + b1;
                    const float y0 = bflo(rr.x) + sigmoidf_(z0[0]) * bflo(pl.x), y1 = bfhi(rr.x) + sigmoidf_(z0[1]) * bfhi(pl.x);
                    const float y2 = bflo(rr.y) + sigmoidf_(z0[2]) * bflo(pl.y), y3 = bfhi(rr.y) + sigmoidf_(z0[3]) * bfhi(pl.y);
                    const float y4 = bflo(rr.z) + sigmoidf_(z1[0]) * bflo(pl.z), y5 = bfhi(rr.z) + sigmoidf_(z1[1]) * bfhi(pl.z);
                    const float y6 = bflo(rr.w) + sigmoidf_(z1[2]) * bflo(pl.w), y7 = bfhi(rr.w) + sigmoidf_(z1[3]) * bfhi(pl.w);
                    u32x4 o; o.x = pk2(y0, y1); o.y = pk2(y2, y3); o.z = pk2(y4, y5); o.w = pk2(y6, y7);
                    *(u32x4*)(ybf + row * DM + c) = o; } }
    }
};

constexpr int KR_OFF = 0, VR_OFF = 9 * 64 * 128, XB_OFF = 2 * VR_OFF, REL_OFF = XB_OFF + 10 * 256 * 4;
constexpr float LOG2E = 1.4426950408889634f;
template <int NT, bool LKA, bool LKB>
__device__ __forceinline__ void attn_tiles(int slotA, int slotB, const bf16x8 q0, const bf16x8 q1, float bconst, const unsigned (&bzA)[8], const unsigned (&bzB)[8],
                                           PG8_LAS const unsigned char* kr, const unsigned (&koff)[2], PG8_LAS const unsigned char* vr, const unsigned (&voff)[4],
                                           float& m_run, float& sum, f32x4 (&o)[4]) {
    f32x4 st[NT * 4];
#pragma unroll
    for (int n = 0; n < NT; ++n) {
        PG8_LAS const unsigned char* kb_ = kr + (n == 0 ? slotA : slotB) * 8192;
#pragma unroll
        for (int ti = 0; ti < 4; ++ti) {
            const bf16x8 k0 = *(PG8_LAS const bf16x8*)(kb_ + ti * 2048 + koff[0]), k1 = *(PG8_LAS const bf16x8*)(kb_ + ti * 2048 + koff[1]);
            f32x4 z = {0.f, 0.f, 0.f, 0.f}; z = mfma16(k0, q0, z); z = mfma16(k1, q1, z); st[n * 4 + ti] = z;
        }
    }
    float mx = m_run;
#pragma unroll
    for (int n = 0; n < NT; ++n)
#pragma unroll
        for (int ti = 0; ti < 4; ++ti)
#pragma unroll
            for (int j = 0; j < 4; ++j) {
                float bias = bconst;
                if (n == 0 ? LKA : LKB) { const unsigned w = (n == 0 ? bzA : bzB)[ti * 2 + (j >> 1)]; bias = (j & 1) ? bfhi(w) : bflo(w); }
                const float sv = st[n * 4 + ti][j] * (0.125f * LOG2E) + bias;
                st[n * 4 + ti][j] = sv; mx = fmaxf(mx, sv);
            }
    mx = max_rows4(mx);
    const float sc = __builtin_amdgcn_exp2f(m_run - mx); m_run = mx;
    float ps = 0.f;
#pragma unroll
    for (int i = 0; i < NT * 4; ++i)
#pragma unroll
        for (int j = 0; j < 4; ++j) { const float pe = __builtin_amdgcn_exp2f(st[i][j] - mx); ps += pe; st[i][j] = pe; }
    sum = sum * sc + ps;
#pragma unroll
    for (int db = 0; db < 4; ++db) o[db] = o[db] * sc;
#pragma unroll
    for (int n = 0; n < NT; ++n) {
        PG8_LAS const unsigned char* sb = vr + (n == 0 ? slotA : slotB) * 8192;
#pragma unroll
        for (int kb = 0; kb < 2; ++kb) {
            const int t0 = n * 4 + 2 * kb;
            u32x4 pw; pw.x = pk2(st[t0][0], st[t0][1]); pw.y = pk2(st[t0][2], st[t0][3]); pw.z = pk2(st[t0 + 1][0], st[t0 + 1][1]); pw.w = pk2(st[t0 + 1][2], st[t0 + 1][3]);
            const bf16x8 pf = __builtin_bit_cast(bf16x8, pw);
#pragma unroll
            for (int db = 0; db < 4; ++db) {
                const s16x4 a0 = tr_read(sb + kb * 4096 + voff[db]), a1 = tr_read(sb + kb * 4096 + 2048 + voff[db]);
                o[db] = mfma16(__builtin_shufflevector(a0, a1, 0, 1, 2, 3, 4, 5, 6, 7), pf, o[db]);
            }
        }
    }
}
__device__ __forceinline__ void attn_unit(const bf16_t* __restrict__ proj, const float* __restrict__ rel_bias, bf16_t* __restrict__ mix, unsigned char* lds, int b, int h, int c_begin, int nsteps) {
    const int tid = opaque_tid(), wave = tid >> 6, lane = tid & 63, l15 = lane & 15, g = lane >> 4;
    PG8_LAS unsigned char* kr = (PG8_LAS unsigned char*)lds + KR_OFF;
    PG8_LAS unsigned char* vr = (PG8_LAS unsigned char*)lds + VR_OFF;
    float* xb = (float*)(lds + XB_OFF);
    float* rl = (float*)(lds + REL_OFF);
    const size_t brow = (size_t)b * SEQ;
    const int qg = wave & 3, kh = wave >> 2, qi = qg * 16 + l15;
    for (int i = tid; i < 257; i += NTHR) rl[i] = rel_bias[h * 257 + i] * LOG2E;
    const int skey = tid >> 3, sch = tid & 7;
    const unsigned kdst = (unsigned)(skey * 128 + ((sch ^ (skey & 7)) * 16));
    const unsigned vdst = (unsigned)(skey * 128 + ((sch ^ (((skey >> 1) & 3) << 1)) * 16));
    const bf16_t* ksrc = proj + (brow + skey) * NPROJ + C_AK + h * 64 + sch * 8;
    const bf16_t* vsrc = proj + (brow + skey) * NPROJ + C_AV + h * 64 + sch * 8;
#pragma unroll
    for (int k = 0; k < 8; ++k) {
        const int ac = c_begin - 8 + k;
        u32x4 kk = {0u, 0u, 0u, 0u}, vv = {0u, 0u, 0u, 0u};
        if (ac >= 0) { kk = *(const u32x4*)(ksrc + (size_t)ac * 64 * NPROJ); vv = *(const u32x4*)(vsrc + (size_t)ac * 64 * NPROJ); }
        const int slot = (ac + 9) % 9;
        *(PG8_LAS u32x4*)(kr + slot * 8192 + kdst) = kk; *(PG8_LAS u32x4*)(vr + slot * 8192 + vdst) = vv;
    }
    unsigned koff[2], voff[4];
#pragma unroll
    for (int ks = 0; ks < 2; ++ks) koff[ks] = (unsigned)(l15 * 128 + (((ks * 4 + g) ^ (l15 & 7)) * 16));
    { const int q = l15 >> 2, p = l15 & 3, sw = ((2 * g + (q >> 1)) & 3) << 1;
#pragma unroll
      for (int db = 0; db < 4; ++db) voff[db] = (unsigned)((4 * g + q) * 128 + (((2 * db + (p >> 1)) ^ sw) * 16) + (p & 1) * 8); }
    lds_barrier();
    unsigned bz[3][8];
#pragma unroll
    for (int bl = 0; bl < 3; ++bl)
#pragma unroll
        for (int ti = 0; ti < 4; ++ti)
#pragma unroll
            for (int jp = 0; jp < 2; ++jp) { int r0 = qi + 512 - ((6 + bl) * 64 + ti * 16 + 4 * g + 2 * jp); int r1 = r0 - 1; r0 = r0 > 128 ? 128 : r0; r1 = r1 > 128 ? 128 : r1; bz[bl][ti * 2 + jp] = pk2(rl[r0 + 128], rl[r1 + 128]); }
    const float bconst = rl[256];
    u32x4 pk = *(const u32x4*)(ksrc + (size_t)c_begin * 64 * NPROJ), pv = *(const u32x4*)(vsrc + (size_t)c_begin * 64 * NPROJ);
    size_t qrow = brow + (size_t)c_begin * 64 + qi;
    bf16x8 qf0 = *(const bf16x8*)(proj + qrow * NPROJ + C_AQ + h * 64 + g * 8), qf1 = *(const bf16x8*)(proj + qrow * NPROJ + C_AQ + h * 64 + 32 + g * 8);
    u32x2 gt[4];
#pragma unroll
    for (int db = 0; db < 4; ++db) gt[db] = *(const u32x2*)(proj + qrow * NPROJ + C_AG + h * 64 + db * 16 + 4 * g);
    const int c_end = c_begin + nsteps;
#pragma unroll 1
    for (int c = c_begin; c < c_end; ++c) {
        lds_barrier();
        { const int slot = c % 9; *(PG8_LAS u32x4*)(kr + slot * 8192 + kdst) = pk; *(PG8_LAS u32x4*)(vr + slot * 8192 + vdst) = pv; }
        const bf16x8 cq0 = qf0, cq1 = qf1; u32x2 cg[4];
#pragma unroll
        for (int db = 0; db < 4; ++db) cg[db] = gt[db];
        const size_t crow = qrow;
        if (c + 1 < c_end) {
            pk = *(const u32x4*)(ksrc + (size_t)(c + 1) * 64 * NPROJ); pv = *(const u32x4*)(vsrc + (size_t)(c + 1) * 64 * NPROJ);
            qrow += 64;
            qf0 = *(const bf16x8*)(proj + qrow * NPROJ + C_AQ + h * 64 + g * 8); qf1 = *(const bf16x8*)(proj + qrow * NPROJ + C_AQ + h * 64 + 32 + g * 8);
#pragma unroll
            for (int db = 0; db < 4; ++db) gt[db] = *(const u32x2*)(proj + qrow * NPROJ + C_AG + h * 64 + db * 16 + 4 * g);
        }
        lds_barrier();
        float m_run = -3.0e38f, sum = 0.f;
        f32x4 o[4];
#pragma unroll
        for (int db = 0; db < 4; ++db) o[db] = (f32x4){0.f, 0.f, 0.f, 0.f};
        const int nskip = 8 - c;
#define ATT1(LK, sl, bzz) attn_tiles<1, LK, false>((sl), 0, cq0, cq1, bconst, bzz, bzz, kr, koff, vr, voff, m_run, sum, o)
#define ATT2(LA, LB, sa, sb_, bza, bzb) attn_tiles<2, LA, LB>((sa), (sb_), cq0, cq1, bconst, bza, bzb, kr, koff, vr, voff, m_run, sum, o)
        if (kh == 0) {
            if (nskip <= 0) { ATT2(false, false, (c + 1) % 9, (c + 2) % 9, bz[0], bz[0]); ATT2(false, false, (c + 3) % 9, (c + 4) % 9, bz[0], bz[0]); ATT1(false, (c + 5) % 9, bz[0]); }
            else {
#pragma unroll 1
                for (int bc = 0; bc < 5; ++bc) if (bc >= nskip) ATT1(false, (c + 1 + bc) % 9, bz[0]);
            }
        } else {
            if (nskip <= 5) { ATT2(false, true, (c + 6) % 9, (c + 7) % 9, bz[0], bz[0]); ATT2(true, true, (c + 8) % 9, c % 9, bz[1], bz[2]); }
            else {
                if (6 >= nskip) ATT1(true, (c + 7) % 9, bz[0]);
                if (7 >= nskip) ATT1(true, (c + 8) % 9, bz[1]);
                ATT1(true, c % 9, bz[2]);
            }
            float* x = xb + qg * 64 + lane;
            x[0] = m_run; x[256] = sum;
#pragma unroll
            for (int db = 0; db < 4; ++db) { x[(2 + 2 * db) * 256] = __builtin_bit_cast(float, pk2(o[db][0], o[db][1])); x[(3 + 2 * db) * 256] = __builtin_bit_cast(float, pk2(o[db][2], o[db][3])); }
        }
        lds_barrier();
        if (kh == 0) {
            const float* x = xb + qg * 64 + lane;
            const float m1 = x[0], s1 = x[256];
            const float m = fmaxf(m_run, m1);
            const float a0 = __builtin_amdgcn_exp2f(m_run - m), a1 = __builtin_amdgcn_exp2f(m1 - m);
            float tot = sum * a0 + s1 * a1;
            tot = sum_rows4(tot);
            const float inv = __builtin_amdgcn_rcpf(tot);
#pragma unroll
            for (int db = 0; db < 4; ++db) {
                const unsigned w0 = __builtin_bit_cast(unsigned, x[(2 + 2 * db) * 256]), w1 = __builtin_bit_cast(unsigned, x[(3 + 2 * db) * 256]);
                const int d0 = db * 16 + 4 * g;
                const float v0 = (o[db][0] * a0 + bflo(w0) * a1) * inv * siluf_(bflo(cg[db].x)), v1 = (o[db][1] * a0 + bfhi(w0) * a1) * inv * siluf_(bfhi(cg[db].x));
                const float v2 = (o[db][2] * a0 + bflo(w1) * a1) * inv * siluf_(bflo(cg[db].y)), v3 = (o[db][3] * a0 + bfhi(w1) * a1) * inv * siluf_(bfhi(cg[db].y));
                u32x2 ov; ov.x = pk2(v0, v1); ov.y = pk2(v2, v3);
                *(u32x2*)(mix + crow * DM + h * 64 + d0) = ov;
            }
        }
    }
    lds_barrier();
}

constexpr int GS = 72;
constexpr int G2_GLR = 0, G2_SEG = 2048, G2_K = 3072, G2_Q = 11264, G2_V = 19456, G2_T = 35840, G2_BYTES = G2_T + 4 * 64 * GS * 2;
__device__ __forceinline__ void gla_gates(const unsigned char* base, const float (&w)[16], float bb, int tq, int d, float (&L)[16], float& Lend) {
    float* segtot = (float*)(base + G2_SEG);
    float run = 0.f;
#pragma unroll
    for (int i = 0; i < 16; ++i) {
        const unsigned char* gp = base + G2_GLR + (tq * 16 + i) * 32;
        const u32x4 a = *(const u32x4*)gp, b2 = *(const u32x4*)(gp + 16);
        float z = bb;
        z += bflo(a.x) * w[0] + bfhi(a.x) * w[1] + bflo(a.y) * w[2] + bfhi(a.y) * w[3] + bflo(a.z) * w[4] + bfhi(a.z) * w[5] + bflo(a.w) * w[6] + bfhi(a.w) * w[7];
        z += bflo(b2.x) * w[8] + bfhi(b2.x) * w[9] + bflo(b2.y) * w[10] + bfhi(b2.y) * w[11] + bflo(b2.z) * w[12] + bfhi(b2.z) * w[13] + bflo(b2.w) * w[14] + bfhi(b2.w) * w[15];
        const float ls = fminf(z, 0.f) - __logf(1.f + __expf(-fabsf(z)));
        run += ls * (1.f / 16.f); L[i] = run;
    }
    segtot[tq * 64 + d] = run;
    lds_barrier();
    float off = 0.f, tot = 0.f;
#pragma unroll
    for (int q = 0; q < 4; ++q) { const float v = segtot[q * 64 + d]; tot += v; if (q < tq) off += v; }
#pragma unroll
    for (int i = 0; i < 16; ++i) L[i] += off;
    Lend = tot;
}
#define GLA_ROW0(item) ((size_t)((item) >> 8) * SEQ + (size_t)(((item) >> 2) & 63) * 64)
__device__ __forceinline__ void gla_kv_phase(const Params& P, const bf16_t* __restrict__ proj, bf16_t* __restrict__ KV, float* __restrict__ DEC, bf16_t* __restrict__ EG, unsigned char* lds) {
    const int tid = opaque_tid(), wave = tid >> 6, lane = tid & 63, l15 = lane & 15, g = lane >> 4, grp = wave >> 2, w4 = wave & 3, tg = tid & 255;
    unsigned char* base = lds + grp * G2_BYTES;
    PG8_LAS const unsigned char* vl = (PG8_LAS const unsigned char*)base + G2_V;
    bf16_t* kendT = (bf16_t*)(base + G2_T);
    const int step = 2 * (int)gridDim.x;
    int item = blockIdx.x * 2 + grp;
    const int h = item & 3;
    float w[16];
#pragma unroll
    for (int r = 0; r < 16; ++r) w[r] = P.w_gla_gate[r * 256 + h * 64 + lane];
    const float bb = P.b_gla_gate[h * 64 + lane];
    const int kt_ = tg >> 3, kch = tg & 7, vs_ = tg >> 4, vch = tg & 15;
    unsigned voff[8];
    { const int q = l15 >> 2, p = l15 & 3, sw = (4 * (g & 1) + q) << 1;
#pragma unroll
      for (int vb = 0; vb < 8; ++vb) voff[vb] = (unsigned)((4 * g + q) * 256 + (((2 * vb + (p >> 1)) ^ sw) * 16) + (p & 1) * 8); }
    u32x4 pg = {0u, 0u, 0u, 0u}, pk[2], pv[4];
#define GLA_PF_KV(it_) do { const bf16_t* r0_ = proj + GLA_ROW0(it_) * NPROJ; \
        if (tg < 128) pg = *(const u32x4*)(r0_ + (size_t)(tg >> 1) * NPROJ + C_LR + (tg & 1) * 8); \
        _Pragma("unroll") for (int i_ = 0; i_ < 2; ++i_) pk[i_] = *(const u32x4*)(r0_ + (size_t)(kt_ + 32 * i_) * NPROJ + C_GK + h * 64 + kch * 8); \
        _Pragma("unroll") for (int i_ = 0; i_ < 4; ++i_) pv[i_] = *(const u32x4*)(r0_ + (size_t)(vs_ + 16 * i_) * NPROJ + C_GV + h * 128 + vch * 8); } while (0)
    GLA_PF_KV(item);
    for (; item < 2048; item += step) {
        lds_barrier();
        if (tg < 128) *(u32x4*)(base + G2_GLR + tg * 16) = pg;
#pragma unroll
        for (int i = 0; i < 2; ++i) *(u32x4*)(base + G2_K + (kt_ + 32 * i) * 128 + kch * 16) = pk[i];
#pragma unroll
        for (int i = 0; i < 4; ++i) { const int sr = vs_ + 16 * i; *(u32x4*)(base + G2_V + sr * 256 + ((vch ^ ((sr & 7) << 1)) * 16)) = pv[i]; }
        const int cur = item;
        if (item + step < 2048) GLA_PF_KV(item + step);
        lds_barrier();
        float L[16], Lend;
        gla_gates(base, w, bb, w4, lane, L, Lend);
#pragma unroll
        for (int i = 0; i < 16; ++i) { const int t = w4 * 16 + i;
            const float kv = bf2f(*(const bf16_t*)(base + G2_K + t * 128 + lane * 2));
            kendT[lane * GS + t] = (bf16_t)f2bf(kv * __expf(Lend - L[i]));
            EG[(size_t)cur * 4096 + t * 64 + lane] = (bf16_t)f2bf(__expf(L[i])); }
        const size_t sidx = (size_t)((cur >> 8) * 4 + h) * 64 + ((cur >> 2) & 63);
        if (w4 == 0) DEC[sidx * 64 + lane] = __expf(Lend);
        lds_barrier();
        bf16_t* kvo = KV + sidx * 8192;
#pragma unroll
        for (int vi = 0; vi < 2; ++vi) { const int vb = 2 * w4 + vi;
            bf16x8 af[2];
#pragma unroll
            for (int kb = 0; kb < 2; ++kb) { const s16x4 a0 = tr_read(vl + kb * 8192 + voff[vb]), a1 = tr_read(vl + kb * 8192 + 4096 + voff[vb]); af[kb] = __builtin_shufflevector(a0, a1, 0, 1, 2, 3, 4, 5, 6, 7); }
#pragma unroll
            for (int db = 0; db < 4; ++db) {
                f32x4 acc = {0.f, 0.f, 0.f, 0.f};
#pragma unroll
                for (int kb = 0; kb < 2; ++kb) {
                    const bf16_t* bp = kendT + (db * 16 + l15) * GS + kb * 32 + 4 * g;
                    const u32x2 b0 = *(const u32x2*)bp, b1 = *(const u32x2*)(bp + 16);
                    u32x4 bw; bw.x = b0.x; bw.y = b0.y; bw.z = b1.x; bw.w = b1.y;
                    acc = mfma16(__builtin_bit_cast(bf16x8, bw), af[kb], acc);
                }
                u32x2 ov; ov.x = pk2(acc[0], acc[1]); ov.y = pk2(acc[2], acc[3]);
                *(u32x2*)(kvo + (vb * 16 + l15) * 64 + db * 16 + 4 * g) = ov;
            } }
    }
    lds_barrier();
#undef GLA_PF_KV
}
constexpr int G3_V = 0, G3_T = 16384, G3_BYTES = G3_T + 4 * 64 * GS * 2;
__device__ __forceinline__ void gla_out_phase(const Params& P, const bf16_t* __restrict__ proj, const bf16_t* __restrict__ SP, const bf16_t* __restrict__ EG, bf16_t* __restrict__ mix, unsigned char* lds) {
    const int tid = opaque_tid(), wave = tid >> 6, lane = tid & 63, l15 = lane & 15, g = lane >> 4, grp = wave >> 2, w4 = wave & 3, tg = tid & 255;
    unsigned char* base = lds + grp * G3_BYTES;
    PG8_LAS const unsigned char* vl = (PG8_LAS const unsigned char*)base + G3_V;
    bf16_t* qfw = (bf16_t*)(base + G3_T); bf16_t* qbw = qfw + 64 * GS; bf16_t* kng = qbw + 64 * GS; bf16_t* kps = kng + 64 * GS;
    const int step = 2 * (int)gridDim.x;
    int item = blockIdx.x * 2 + grp;
    const int h = item & 3;
    const int kt_ = tg >> 3, kch = tg & 7, vs_ = tg >> 4, vch = tg & 15;
    unsigned voff[8];
    { const int q = l15 >> 2, p = l15 & 3, sw = (4 * (g & 1) + q) << 1;
#pragma unroll
      for (int vb = 0; vb < 8; ++vb) voff[vb] = (unsigned)((4 * g + q) * 256 + (((2 * vb + (p >> 1)) ^ sw) * 16) + (p & 1) * 8); }
    const int tb = w4, tl = tb * 16 + l15;
    u32x4 pk[2], pq[2], pe[2], pv[4];
#define GLA_PF_OUT(it_) do { const bf16_t* r0_ = proj + GLA_ROW0(it_) * NPROJ; const bf16_t* e0_ = EG + (size_t)(it_) * 4096; \
        _Pragma("unroll") for (int i_ = 0; i_ < 2; ++i_) { pk[i_] = *(const u32x4*)(r0_ + (size_t)(kt_ + 32 * i_) * NPROJ + C_GK + h * 64 + kch * 8); \
                                                          pq[i_] = *(const u32x4*)(r0_ + (size_t)(kt_ + 32 * i_) * NPROJ + C_GQ + h * 64 + kch * 8); \
                                                          pe[i_] = *(const u32x4*)(e0_ + (kt_ + 32 * i_) * 64 + kch * 8); } \
        _Pragma("unroll") for (int i_ = 0; i_ < 4; ++i_) pv[i_] = *(const u32x4*)(r0_ + (size_t)(vs_ + 16 * i_) * NPROJ + C_GV + h * 128 + vch * 8); } while (0)
    GLA_PF_OUT(item);
    for (; item < 2048; item += step) {
        lds_barrier();
#pragma unroll
        for (int i = 0; i < 2; ++i) {
            u32x4 wf, wb, wn, wp;
#pragma unroll
            for (int c2 = 0; c2 < 4; ++c2) {
                const unsigned qq = pq[i][c2], kk = pk[i][c2], ee = pe[i][c2];
                const float e0 = bflo(ee), e1 = bfhi(ee), r0 = __builtin_amdgcn_rcpf(e0), r1 = __builtin_amdgcn_rcpf(e1);
                const float q0 = bflo(qq) * 0.125f, q1 = bfhi(qq) * 0.125f, k0 = bflo(kk), k1 = bfhi(kk);
                wf[c2] = pk2(q0 * e0, q1 * e1); wb[c2] = pk2(q0 * r0, q1 * r1); wn[c2] = pk2(k0 * r0, k1 * r1); wp[c2] = pk2(k0 * e0, k1 * e1);
            }
            const int off = (kt_ + 32 * i) * GS + kch * 8;
            *(u32x4*)(qfw + off) = wf; *(u32x4*)(qbw + off) = wb; *(u32x4*)(kng + off) = wn; *(u32x4*)(kps + off) = wp;
        }
#pragma unroll
        for (int i = 0; i < 4; ++i) { const int sr = vs_ + 16 * i; *(u32x4*)(base + G3_V + sr * 256 + ((vch ^ ((sr & 7) << 1)) * 16)) = pv[i]; }
        const int cur = item;
        if (item + step < 2048) GLA_PF_OUT(item + step);
        const size_t row0 = GLA_ROW0(cur);
        const size_t trow = row0 + tl;
        const bf16_t* sp = SP + ((size_t)((cur >> 8) * 4 + h) * 64 + ((cur >> 2) & 63)) * 8192;
        u32x2 gt[8]; f32x4 gnv[8];
#pragma unroll
        for (int vb = 0; vb < 8; ++vb) { gt[vb] = *(const u32x2*)(proj + trow * NPROJ + C_GG + h * 128 + vb * 16 + 4 * g); gnv[vb] = *(const f32x4*)(P.gla_norm_g + h * 128 + vb * 16 + 4 * g); }
        lds_barrier();
        bf16x8 sf[8][2];
#pragma unroll
        for (int vb = 0; vb < 8; ++vb)
#pragma unroll
            for (int ks = 0; ks < 2; ++ks) sf[vb][ks] = *(const bf16x8*)(sp + (vb * 16 + l15) * 64 + ks * 32 + g * 8);
        bf16x8 qF[2], qB[2];
#pragma unroll
        for (int ks = 0; ks < 2; ++ks) { qF[ks] = *(const bf16x8*)(qfw + tl * GS + ks * 32 + g * 8); qB[ks] = *(const bf16x8*)(qbw + tl * GS + ks * 32 + g * 8); }
        f32x4 o[8];
#pragma unroll
        for (int vb = 0; vb < 8; ++vb) o[vb] = (f32x4){0.f, 0.f, 0.f, 0.f};
        f32x4 at[4];
#pragma unroll
        for (int sb = 0; sb < 4; ++sb) {
            const bf16_t* kn = kng + (sb * 16 + l15) * GS + g * 8; const bf16_t* kp = kps + (sb * 16 + l15) * GS + g * 8;
            f32x4 ca = {0.f, 0.f, 0.f, 0.f}, an = {0.f, 0.f, 0.f, 0.f};
            ca = mfma16(*(const bf16x8*)kn, qF[0], ca); ca = mfma16(*(const bf16x8*)(kn + 32), qF[1], ca);
            an = mfma16(*(const bf16x8*)kp, qB[0], an); an = mfma16(*(const bf16x8*)(kp + 32), qB[1], an);
#pragma unroll
            for (int j = 0; j < 4; ++j) { const int sx = sb * 16 + 4 * g + j; at[sb][j] = (sx <= tl) ? ca[j] : an[j]; }
        }
#pragma unroll
        for (int kb = 0; kb < 2; ++kb) {
            u32x4 pw; pw.x = pk2(at[2 * kb][0], at[2 * kb][1]); pw.y = pk2(at[2 * kb][2], at[2 * kb][3]); pw.z = pk2(at[2 * kb + 1][0], at[2 * kb + 1][1]); pw.w = pk2(at[2 * kb + 1][2], at[2 * kb + 1][3]);
            const bf16x8 pf = __builtin_bit_cast(bf16x8, pw);
#pragma unroll
            for (int vb = 0; vb < 8; ++vb) {
                const s16x4 a0 = tr_read(vl + kb * 8192 + voff[vb]), a1 = tr_read(vl + kb * 8192 + 4096 + voff[vb]);
                o[vb] = mfma16(__builtin_shufflevector(a0, a1, 0, 1, 2, 3, 4, 5, 6, 7), pf, o[vb]);
            }
        }
#pragma unroll
        for (int vb = 0; vb < 8; ++vb) { o[vb] = mfma16(sf[vb][0], qF[0], o[vb]); o[vb] = mfma16(sf[vb][1], qF[1], o[vb]); }
        float ss = 0.f;
#pragma unroll
        for (int vb = 0; vb < 8; ++vb)
#pragma unroll
            for (int j = 0; j < 4; ++j) ss += o[vb][j] * o[vb][j];
        ss = sum_rows4(ss);
        const float rs = __builtin_amdgcn_rsqf(ss * (1.f / 128.f) + 1e-6f);
#pragma unroll
        for (int vb = 0; vb < 8; ++vb) {
            const int v0 = vb * 16 + 4 * g;
            const f32x4 gn = gnv[vb];
            const float y0 = o[vb][0] * rs * gn[0] * siluf_(bflo(gt[vb].x)), y1 = o[vb][1] * rs * gn[1] * siluf_(bfhi(gt[vb].x));
            const float y2 = o[vb][2] * rs * gn[2] * siluf_(bflo(gt[vb].y)), y3 = o[vb][3] * rs * gn[3] * siluf_(bfhi(gt[vb].y));
            u32x2 ov; ov.x = pk2(y0, y1); ov.y = pk2(y2, y3);
            *(u32x2*)(mix + trow * DM + 512 + h * 128 + v0) = ov;
        }
    }
    lds_barrier();
#undef GLA_PF_OUT
}

#define XB_TMO      128
#define XB_XCNT(j)  (256  + 64 * (j))
#define XB_XSUB(j)  (1280 + 64 * (j))
#define XB_XGEN(j)  (2304 + 64 * (j))
#define XB_TOP      3328
#define XB_TOPGEN   3392
#define XCD_BAR_WORDS 3456
#define XB_SPIN_CAP (1u << 18)
__device__ __forceinline__ unsigned xb_ld(unsigned* p)              { return __hip_atomic_load(p, __ATOMIC_RELAXED, __HIP_MEMORY_SCOPE_AGENT); }
__device__ __forceinline__ unsigned xb_add(unsigned* p, unsigned v) { return __hip_atomic_fetch_add(p, v, __ATOMIC_RELAXED, __HIP_MEMORY_SCOPE_AGENT); }
__device__ __forceinline__ unsigned xb_xcc_id() { return (unsigned)__builtin_amdgcn_s_getreg((3 << 11) | 20) & 0xFu; }
#define XB_SPIN(cond, bar) do { unsigned _sp = 0; while (cond) { __builtin_amdgcn_s_sleep(1); \
    if ((++_sp & 255u) == 0u) { if (xb_ld(&(bar)[XB_TMO])) break; if (_sp > XB_SPIN_CAP) { atomicAdd(&(bar)[XB_TMO], 1u); break; } } } } while (0)
struct XcdBarrier { unsigned* bar; unsigned x; volatile PG8_LAS unsigned* st; };
__device__ __forceinline__ XcdBarrier xcd_barrier_post(unsigned* bar, volatile PG8_LAS unsigned* st) {
    XcdBarrier b; b.bar = bar; b.x = xb_xcc_id(); b.st = st;
    if (threadIdx.x == 0) (void)xb_add(&bar[XB_XCNT(b.x)], 1u);
    return b;
}
__device__ __forceinline__ void xcd_barrier_complete(unsigned* bar, unsigned x, unsigned& nloc, unsigned& nx) {
    const unsigned G = gridDim.x * gridDim.y * gridDim.z;
    unsigned sum, cnt, mine, sp = 0u;
    for (;;) {
        sum = 0u; cnt = 0u; mine = 0u;
#pragma unroll
        for (unsigned j = 0; j < 16; ++j) { const unsigned c = xb_ld(&bar[XB_XCNT(j)]); sum += c; cnt += (c > 0u) ? 1u : 0u; mine = (j == x) ? c : mine; }
        if (sum == G) break;
        __builtin_amdgcn_s_sleep(1);
        if ((++sp & 255u) == 0u) { if (xb_ld(&bar[XB_TMO])) break; if (sp > XB_SPIN_CAP) { atomicAdd(&bar[XB_TMO], 1u); break; } }
    }
    nloc = mine > 0u ? mine : 1u; nx = cnt > 0u ? cnt : 1u;
}
__device__ __forceinline__ void xcd_barrier(const XcdBarrier& b) {
    asm volatile("s_waitcnt vmcnt(0)" ::: "memory");
    __syncthreads();
    if (threadIdx.x == 0) {
        unsigned* bar = b.bar;
        __builtin_amdgcn_s_waitcnt(0);
        unsigned nloc = b.st[0], nx = b.st[1];
        if (nloc == 0u) { xcd_barrier_complete(bar, b.x, nloc, nx); b.st[0] = nloc; b.st[1] = nx; }
        const unsigned old = xb_add(&bar[XB_XSUB(b.x)], 1u);
        const unsigned gen = old / nloc;
        if (old + 1u == (gen + 1u) * nloc) {
            __builtin_amdgcn_fence(__ATOMIC_RELEASE, "agent");
            asm volatile("s_waitcnt vmcnt(0)" ::: "memory");
            const unsigned og = xb_add(&bar[XB_TOP], 1u);
            const unsigned tg = og / nx;
            if (og + 1u == (tg + 1u) * nx) xb_add(&bar[XB_TOPGEN], 1u);
            else XB_SPIN(xb_ld(&bar[XB_TOPGEN]) == tg, bar);
            __builtin_amdgcn_fence(__ATOMIC_ACQUIRE, "agent");
            xb_add(&bar[XB_XGEN(b.x)], 1u);
            asm volatile("s_waitcnt vmcnt(0)" ::: "memory");
        } else {
            XB_SPIN(xb_ld(&bar[XB_XGEN(b.x)]) == gen, bar);
            __builtin_amdgcn_fence(__ATOMIC_ACQUIRE, "agent");
            asm volatile("s_waitcnt vmcnt(0)" ::: "memory");
        }
    }
    __syncthreads();
}

__global__ void __launch_bounds__(NTHR, 2) fwd_megakernel(Params P) {
    extern __shared__ __attribute__((aligned(16))) unsigned char lds[];
    cg::grid_group grid = cg::this_grid();
    const int tid = threadIdx.x, wave = tid >> 6, lane = tid & 63;
    unsigned char* ws = P.ws;
    bf16_t* proj = (bf16_t*)(ws + WS_PROJ); bf16_t* mix = (bf16_t*)(ws + WS_MIX); bf16_t* KVB = (bf16_t*)(ws + WS_KV); float* DEC = (float*)(ws + WS_DEC);
    const int G = gridDim.x;
    { volatile PG8_LAS unsigned* z = (volatile PG8_LAS unsigned*)((PG8_LAS unsigned char*)lds + LDS_BYTES - 16); if (tid < 4) z[tid] = 0u; }
    __syncthreads();
    const XcdBarrier xbar = xcd_barrier_post((unsigned*)(ws + WS_BAR), (volatile PG8_LAS unsigned*)((PG8_LAS unsigned char*)lds + LDS_BYTES - 16));
    if (P.ws == nullptr) grid.sync();

    prep_phase(P, lds);
    xcd_barrier(xbar);
    {
        pg8::Gemm gm{(const bf16_t*)(ws + WS_HBF), (const bf16_t*)(ws + WS_WIN), T_TOK, 3584, DM}; pg8::StaticOrder S; S.init(T_TOK, 3584, G, (int)blockIdx.x);
        EpiBf16 E{proj, NPROJ, NPROJ};
        pg8::gemm_phase<EpiBf16, pg8::StaticOrder, true, true>((PG8_LAS unsigned char*)lds, gm, S, E);
    }
    {
        const int lane_ = tid & 63, l15 = lane_ & 15, g4 = lane_ >> 4;
        const bf16_t* hb = (const bf16_t*)(ws + WS_HBF); const bf16_t* wl = (const bf16_t*)(ws + WS_WIN) + (size_t)3584 * DM;
        for (int rg = blockIdx.x * NWAVES + (tid >> 6); rg < T_TOK / 16; rg += G * NWAVES) {
            const bf16_t* ap = hb + (size_t)(rg * 16 + l15) * DM + g4 * 8; const bf16_t* bp = wl + (size_t)l15 * DM + g4 * 8;
            f32x4 acc0 = {0.f, 0.f, 0.f, 0.f}, acc1 = {0.f, 0.f, 0.f, 0.f};
#pragma unroll 8
            for (int ks = 0; ks < 32; ks += 2) {
                acc0 = mfma16(*(const bf16x8*)(bp + ks * 32), *(const bf16x8*)(ap + ks * 32), acc0);
                acc1 = mfma16(*(const bf16x8*)(bp + ks * 32 + 32), *(const bf16x8*)(ap + ks * 32 + 32), acc1);
            }
            const f32x4 r = acc0 + acc1;
            u32x2 o; o.x = pk2(r[0], r[1]); o.y = pk2(r[2], r[3]);
            *(u32x2*)(proj + (size_t)(rg * 16 + l15) * NPROJ + C_LR + 4 * g4) = o;
        }
    }
    xcd_barrier(xbar);
#ifndef NO_ATTN
    for (int rep = 0; rep < DUP_ATTN; ++rep)
    for (int u0 = blockIdx.x; u0 < 256; u0 += G) { const int u = (G == 256) ? ((u0 & 7) * 32 + (u0 >> 3)) : u0;
        attn_unit(proj, P.rel_bias, mix, lds, u >> 5, (u >> 2) & 7, (u & 3) * 16, 16); }
#endif
    for (int rep = 0; rep < DUP_KV; ++rep) gla_kv_phase(P, proj, KVB, DEC, (bf16_t*)(ws + WS_EG), lds);
    xcd_barrier(xbar);
#ifndef DUP_SCAN
#define DUP_SCAN 1
#endif
    for (int rep = 0; rep < DUP_SCAN; ++rep)
    for (int e = blockIdx.x * NTHR + tid; e < 32 * 2048; e += G * NTHR) {
        const int bh = e >> 11, vd = (e & 2047) * 4, d = vd & 63;
        const bf16_t* __restrict__ kvp = KVB + (size_t)bh * 64 * 8192 + vd; const float* __restrict__ dp = DEC + (size_t)bh * 64 * 64 + d;
        bf16_t* __restrict__ spo = (bf16_t*)(ws + WS_SPREV) + (size_t)bh * 64 * 8192 + vd;
        f32x4 stt = {0.f, 0.f, 0.f, 0.f};
#pragma unroll 1
        for (int c0 = 0; c0 < 64; c0 += 8) {
            u32x2 kv[8]; f32x4 dc[8];
#pragma unroll
            for (int u = 0; u < 8; ++u) { kv[u] = __builtin_nontemporal_load((const u32x2*)(kvp + (size_t)(c0 + u) * 8192)); dc[u] = *(const f32x4*)(dp + (c0 + u) * 64); }
#pragma unroll
            for (int u = 0; u < 8; ++u) { u32x2 o; o.x = pk2(stt[0], stt[1]); o.y = pk2(stt[2], stt[3]); *(u32x2*)(spo + (size_t)(c0 + u) * 8192) = o;
                const f32x4 kf = {bflo(kv[u].x), bfhi(kv[u].x), bflo(kv[u].y), bfhi(kv[u].y)}; stt = dc[u] * stt + kf; }
        }
    }
    xcd_barrier(xbar);
    for (int rep = 0; rep < DUP_OUT; ++rep) gla_out_phase(P, proj, (const bf16_t*)(ws + WS_SPREV), (const bf16_t*)(ws + WS_EG), mix, lds);
    xcd_barrier(xbar);
    {
        pg8::Gemm gm{mix, (const bf16_t*)(ws + WS_WOUT), T_TOK, DM, DM}; pg8::StaticOrder S; S.init(T_TOK, DM, G, (int)blockIdx.x);
        EpiRes E{(const bf16_t*)(ws + WS_HBF), (bf16_t*)(ws + WS_R32)};
        pg8::gemm_phase<EpiRes, pg8::StaticOrder, true, true>((PG8_LAS unsigned char*)lds, gm, S, E);
    }
    {
        pg8::Gemm gm{(const bf16_t*)(ws + WS_PBF), (const bf16_t*)(ws + WS_WP), T_TOK, DM, DPLE}; pg8::StaticOrder S; S.init(T_TOK, DM, G, (int)blockIdx.x);
        EpiBf16 E{proj, DM, DM};
        pg8::gemm_phase<EpiBf16, pg8::StaticOrder, true, true>((PG8_LAS unsigned char*)lds, gm, S, E);
    }
    xcd_barrier(xbar);
    {
        pg8::Gemm gm{(const bf16_t*)(ws + WS_R32), (const bf16_t*)(ws + WS_WG), T_TOK, DM, DM}; pg8::StaticOrder S; S.init(T_TOK, DM, G, (int)blockIdx.x);
        EpiGate E{P.b_ple_gate, proj, (const bf16_t*)(ws + WS_R32), (bf16_t*)(ws + WS_KV)};
        pg8::gemm_phase<EpiGate, pg8::StaticOrder, true, true>((PG8_LAS unsigned char*)lds, gm, S, E);
    }
    xcd_barrier(xbar);
    {
        const bf16_t* ybf = (const bf16_t*)(ws + WS_KV);
        f32x4 gg[4], bb[4];
#pragma unroll
        for (int j = 0; j < 4; ++j) { gg[j] = ((const f32x4*)P.ln_g)[lane + 64 * j]; bb[j] = ((const f32x4*)P.ln_b)[lane + 64 * j]; }
        for (int m = blockIdx.x * NWAVES + wave; m < T_TOK; m += 2 * G * NWAVES) {
            const int m2 = m + G * NWAVES;
            const bool has2 = m2 < T_TOK;
            const u32x2* yr = (const u32x2*)(ybf + (size_t)m * DM) + lane;
            const u32x2* yr2 = (const u32x2*)(ybf + (size_t)(has2 ? m2 : m) * DM) + lane;
            u32x2 t[4], t2[4];
#pragma unroll
            for (int j = 0; j < 4; ++j) { t[j] = __builtin_nontemporal_load(&yr[64 * j]); t2[j] = __builtin_nontemporal_load(&yr2[64 * j]); }
            f32x4 v[4], w[4]; float s = 0.f, sb = 0.f;
#pragma unroll
            for (int j = 0; j < 4; ++j) { v[j] = (f32x4){bflo(t[j].x), bfhi(t[j].x), bflo(t[j].y), bfhi(t[j].y)}; s += (v[j].x + v[j].y) + (v[j].z + v[j].w);
                                          w[j] = (f32x4){bflo(t2[j].x), bfhi(t2[j].x), bflo(t2[j].y), bfhi(t2[j].y)}; sb += (w[j].x + w[j].y) + (w[j].z + w[j].w); }
            const float mean = wave_sum(s) * (1.f / DM), meanb = wave_sum(sb) * (1.f / DM); float s2 = 0.f, s2b = 0.f;
#pragma unroll
            for (int j = 0; j < 4; ++j) { v[j] = v[j] - mean; s2 += (v[j].x * v[j].x + v[j].y * v[j].y) + (v[j].z * v[j].z + v[j].w * v[j].w);
                                          w[j] = w[j] - meanb; s2b += (w[j].x * w[j].x + w[j].y * w[j].y) + (w[j].z * w[j].z + w[j].w * w[j].w); }
            const float rstd = __builtin_amdgcn_rsqf(wave_sum(s2) * (1.f / DM) + 1e-5f), rstdb = __builtin_amdgcn_rsqf(wave_sum(s2b) * (1.f / DM) + 1e-5f);
            f32x4* orow = (f32x4*)(P.out + (size_t)m * DM) + lane;
#pragma unroll
            for (int j = 0; j < 4; ++j) __builtin_nontemporal_store(v[j] * rstd * gg[j] + bb[j], &orow[64 * j]);
            if (has2) { f32x4* orow2 = (f32x4*)(P.out + (size_t)m2 * DM) + lane;
#pragma unroll
                for (int j = 0; j < 4; ++j) __builtin_nontemporal_store(w[j] * rstdb * gg[j] + bb[j], &orow2[64 * j]); }
        }
    }
}

extern "C" void kernel_launch(void* const* d_in, const int* in_sizes, int n_in, void* d_out, int out_size, void* d_ws, size_t ws_size, hipStream_t stream) {
    static int grid_blocks = 0;
    if (grid_blocks == 0) {
        if (n_in != 15 || out_size != T_TOK * DM || ws_size < WS_END) { fprintf(stderr, "kernel_launch: unexpected shapes (n_in %d out %d ws %zu need %zu)\n", n_in, out_size, ws_size, (size_t)WS_END); grid_blocks = -1; return; }
        int dev = 0, cus = 0, per_cu = 0;
        hipGetDevice(&dev); hipDeviceGetAttribute(&cus, hipDeviceAttributeMultiprocessorCount, dev);
        if (hipFuncSetAttribute((const void*)fwd_megakernel, hipFuncAttributeMaxDynamicSharedMemorySize, LDS_BYTES) != hipSuccess) { fprintf(stderr, "kernel_launch: hipFuncSetAttribute failed\n"); grid_blocks = -1; return; }
        if (hipOccupancyMaxActiveBlocksPerMultiprocessor(&per_cu, (const void*)fwd_megakernel, NTHR, LDS_BYTES) != hipSuccess || per_cu < 1) { fprintf(stderr, "kernel_launch: occupancy query gave %d\n", per_cu); per_cu = 1; }
        (void)hipGetLastError();
        grid_blocks = cus;
    }
    if (grid_blocks < 0) return;
    Params P{};
    P.x = (const float*)d_in[0]; P.p = (const float*)d_in[1]; P.ln_in_g = (const float*)d_in[2]; P.ln_in_b = (const float*)d_in[3]; P.w_in = (const float*)d_in[4];
    P.w_gla_gate = (const float*)d_in[5]; P.b_gla_gate = (const float*)d_in[6]; P.rel_bias = (const float*)d_in[7]; P.gla_norm_g = (const float*)d_in[8];
    P.w_out = (const float*)d_in[9]; P.w_ple = (const float*)d_in[10]; P.w_ple_gate = (const float*)d_in[11]; P.b_ple_gate = (const float*)d_in[12];
    P.ln_g = (const float*)d_in[13]; P.ln_b = (const float*)d_in[14]; P.out = (float*)d_out; P.ws = (unsigned char*)d_ws;
    if (hipMemsetAsync((unsigned char*)d_ws + WS_BAR, 0, 16384, stream) != hipSuccess) { fprintf(stderr, "kernel_launch: memset failed\n"); return; }
    void* args[] = {&P};
    hipError_t e = hipLaunchCooperativeKernel((const void*)fwd_megakernel, dim3(grid_blocks), dim3(NTHR), args, LDS_BYTES, stream);
    if (e != hipSuccess) fprintf(stderr, "cooperative launch failed: %s (grid %d)\n", hipGetErrorString(e), grid_blocks);
}
```
